# Optimizing an MI355X kernel written in HIP

```python
import jax, jax.numpy as jnp
from jax import lax
import numpy as np

D_MODEL = 2048
BATCH = 4
SEQ = 2048
DEPTH = 4

POOL_WINDOWS = (2, 4, 8, 16)
POOL_GROUPS = len(POOL_WINDOWS)
POOL_GROUP_DIM = D_MODEL // 8
POOL_WIDTH = POOL_GROUPS * POOL_GROUP_DIM
FOX_HEAD_DIM = 128
FOX_HEADS = D_MODEL // (2 * FOX_HEAD_DIM)
FOX_WIDTH = FOX_HEADS * FOX_HEAD_DIM
RET_HEAD_DIM = 128
RET_HEADS = D_MODEL // (2 * RET_HEAD_DIM)
RET_WIDTH = RET_HEADS * RET_HEAD_DIM
ROPE_BASE = 10000.0
N_BRANCHES = 3
D_FF = ((8 * D_MODEL // 3 + 255) // 256) * 256
BLOCK = 128
RMS_EPS = 1e-6
GN_EPS = 1e-5
FORGET_BIAS_MEAN = 2.0

IN_SPLITS = (POOL_WIDTH,
             FOX_WIDTH, FOX_WIDTH, FOX_WIDTH,
             FOX_HEADS,
             RET_WIDTH, RET_WIDTH, RET_WIDTH,
             RET_WIDTH,
             N_BRANCHES * D_MODEL)
IN_WIDTH = sum(IN_SPLITS)
IN_INDICES = tuple(int(i) for i in np.cumsum(IN_SPLITS)[:-1])

kernel_name = "hybrid_pool_fox_retention_macaron"

F32 = jnp.float32


def rms_norm(x, g):
    xf = x.astype(F32)
    y = xf * lax.rsqrt(jnp.mean(xf * xf, axis=-1, keepdims=True) + RMS_EPS) * g.astype(F32)
    return y.astype(x.dtype)


def swiglu(h, w13, w2):
    a, b = jnp.split(h @ w13, 2, axis=-1)
    return (jax.nn.silu(a) * b) @ w2


def rotary(x, pos):
    half = x.shape[-1] // 2
    inv_freq = ROPE_BASE ** (-jnp.arange(half, dtype=F32) / half)
    ang = pos.astype(F32)[:, None] * inv_freq[None, :]
    cos = jnp.cos(ang)[None, :, None, :]
    sin = jnp.sin(ang)[None, :, None, :]
    xf = x.astype(F32)
    x1, x2 = xf[..., :half], xf[..., half:]
    return jnp.concatenate([x1 * cos - x2 * sin, x1 * sin + x2 * cos], axis=-1).astype(x.dtype)


def pool_mixer(u, w_pool, scale):
    b, s, _ = u.shape
    ug = u.reshape(b, s, POOL_GROUPS, POOL_GROUP_DIM).astype(F32)
    csum = jnp.cumsum(ug, axis=1)
    t = jnp.arange(s)
    means = []
    for g, w in enumerate(POOL_WINDOWS):
        cg = jnp.pad(csum[:, :, g], ((0, 0), (w, 0), (0, 0)))
        win_sum = cg[:, w:] - cg[:, :s]
        cnt = jnp.minimum(t + 1, w).astype(F32)[None, :, None]
        means.append(win_sum / cnt)
    pooled = jnp.stack(means, axis=2) - ug
    mixed = jnp.einsum('bsgi,gio->bsgo', pooled, w_pool.astype(F32))
    out = mixed.reshape(b, s, POOL_WIDTH) * scale.astype(F32)
    return out.astype(u.dtype)


def forgetting_attention(q, k, v, f_logit, f_bias):
    b, s, h, dh = q.shape
    log_f = jax.nn.log_sigmoid(f_logit.astype(F32) + f_bias.astype(F32))
    cum_f = jnp.cumsum(log_f, axis=1).transpose(0, 2, 1)
    qh, kh, vh = (a.transpose(0, 2, 1, 3) for a in (q, k, v))
    scale = dh ** -0.5
    local = jnp.arange(BLOCK)
    causal = local[:, None] >= local[None, :]
    outs = []
    for i in range(s // BLOCK):
        q0, q1 = i * BLOCK, (i + 1) * BLOCK
        kb, vb = kh[:, :, :q1], vh[:, :, :q1]
        logits = jnp.einsum('bhqd,bhkd->bhqk', qh[:, :, q0:q1], kb,
                            preferred_element_type=F32) * scale
        logits = logits + cum_f[:, :, q0:q1, None] - cum_f[:, :, None, :q1]
        mask = jnp.concatenate([jnp.ones((BLOCK, q0), dtype=bool), causal], axis=1)
        logits = jnp.where(mask[None, None], logits, -jnp.inf)
        p = jax.nn.softmax(logits, axis=-1)
        outs.append(jnp.einsum('bhqk,bhkd->bqhd', p.astype(vb.dtype), vb))
    return jnp.concatenate(outs, axis=1).reshape(b, s, h * dh)


def retention(q, k, v, gate):
    b, s, h, dh = q.shape
    n = s // BLOCK
    log_gamma = jnp.log1p(-jnp.power(2.0, -5.0 - jnp.arange(h, dtype=F32)))
    pos = jnp.arange(BLOCK, dtype=F32)
    diff = pos[:, None] - pos[None, :]
    inner_decay = jnp.where(diff[None] >= 0,
                            jnp.exp(jnp.maximum(diff, 0.0)[None] * log_gamma[:, None, None]),
                            0.0)
    xi = jnp.exp((pos + 1.0)[None, :] * log_gamma[:, None])
    zeta = jnp.exp((BLOCK - 1.0 - pos)[None, :] * log_gamma[:, None])
    chunk_decay = jnp.exp(BLOCK * log_gamma)

    qc = q.astype(F32).reshape(b, n, BLOCK, h, dh)
    kc = k.astype(F32).reshape(b, n, BLOCK, h, dh) * (dh ** -0.5)
    vc = v.astype(F32).reshape(b, n, BLOCK, h, dh)

    scores = jnp.einsum('bnqhd,bnkhd->bnhqk', qc, kc) * inner_decay[None, None]
    o_inner = jnp.einsum('bnhqk,bnkhe->bnqhe', scores, vc)

    kv = jnp.einsum('bnkhd,hk,bnkhe->bnhde', kc, zeta, vc)

    def step(state, kv_chunk):
        return chunk_decay[None, :, None, None] * state + kv_chunk, state

    _, prev = lax.scan(step, jnp.zeros((b, h, dh, dh), F32), kv.transpose(1, 0, 2, 3, 4))
    prev = prev.transpose(1, 0, 2, 3, 4)
    o_cross = jnp.einsum('bnqhd,hq,bnhde->bnqhe', qc, xi, prev)

    o = (o_inner + o_cross).reshape(b, s, h, dh)
    mu = jnp.mean(o, axis=-1, keepdims=True)
    var = jnp.mean(jnp.square(o - mu), axis=-1, keepdims=True)
    o = ((o - mu) * lax.rsqrt(var + GN_EPS)).reshape(b, s, h * dh)
    return (jax.nn.silu(gate.astype(F32)) * o).astype(q.dtype)


def hybrid_mixer(hn, w_in, forget_bias, pool_w, pool_scale,
                 w_branch_pool, w_branch_fox, w_branch_ret, w_out):
    b, s, d = hn.shape
    z = hn @ w_in
    (u_pool, fq, fk, fv, f_logit, rq, rk, rv, rgate, gate_logits) = jnp.split(z, IN_INDICES, axis=-1)
    pos = jnp.arange(s)

    y_pool = pool_mixer(u_pool, pool_w, pool_scale)

    hsplit = lambda a, nh, hd: a.reshape(b, s, nh, hd)
    y_fox = forgetting_attention(hsplit(fq, FOX_HEADS, FOX_HEAD_DIM),
                                 hsplit(fk, FOX_HEADS, FOX_HEAD_DIM),
                                 hsplit(fv, FOX_HEADS, FOX_HEAD_DIM),
                                 f_logit, forget_bias)

    y_ret = retention(rotary(hsplit(rq, RET_HEADS, RET_HEAD_DIM), pos),
                      rotary(hsplit(rk, RET_HEADS, RET_HEAD_DIM), pos),
                      hsplit(rv, RET_HEADS, RET_HEAD_DIM), rgate)

    gates = jax.nn.sigmoid(gate_logits.astype(F32)).reshape(b, s, N_BRANCHES, d)
    merged = (gates[:, :, 0] * (y_pool @ w_branch_pool).astype(F32)
              + gates[:, :, 1] * (y_fox @ w_branch_fox).astype(F32)
              + gates[:, :, 2] * (y_ret @ w_branch_ret).astype(F32))
    return merged.astype(hn.dtype) @ w_out


def setup_inputs(seed: int = 0) -> dict:
    key = jax.random.key(seed)
    ks = jax.random.split(key, 20)

    def nrm(k, shape, fan_in):
        return jax.random.normal(k, shape, F32) * (fan_in ** -0.5)

    def gain(k, shape):
        return 1.0 + 0.05 * jax.random.normal(k, shape, F32)

    return {
        "x": jax.random.normal(ks[0], (BATCH, SEQ, D_MODEL), F32),
        "ffn1_norm": gain(ks[1], (DEPTH, D_MODEL)),
        "ffn1_w13": nrm(ks[2], (DEPTH, D_MODEL, 2 * D_FF), D_MODEL),
        "ffn1_w2": nrm(ks[3], (DEPTH, D_FF, D_MODEL), D_FF),
        "mix_norm": gain(ks[4], (DEPTH, D_MODEL)),
        "w_in": nrm(ks[5], (DEPTH, D_MODEL, IN_WIDTH), D_MODEL),
        "forget_bias": FORGET_BIAS_MEAN + 0.5 * jax.random.normal(ks[6], (DEPTH, FOX_HEADS), F32),
        "pool_w": nrm(ks[7], (DEPTH, POOL_GROUPS, POOL_GROUP_DIM, POOL_GROUP_DIM), POOL_GROUP_DIM),
        "pool_scale": 1.0 + 0.1 * jax.random.normal(ks[8], (DEPTH, POOL_WIDTH), F32),
        "w_branch_pool": nrm(ks[9], (DEPTH, POOL_WIDTH, D_MODEL), POOL_WIDTH),
        "w_branch_fox": nrm(ks[10], (DEPTH, FOX_WIDTH, D_MODEL), FOX_WIDTH),
        "w_branch_ret": nrm(ks[11], (DEPTH, RET_WIDTH, D_MODEL), RET_WIDTH),
        "w_out": nrm(ks[12], (DEPTH, D_MODEL, D_MODEL), D_MODEL),
        "ffn2_norm": gain(ks[13], (DEPTH, D_MODEL)),
        "ffn2_w13": nrm(ks[14], (DEPTH, D_MODEL, 2 * D_FF), D_MODEL),
        "ffn2_w2": nrm(ks[15], (DEPTH, D_FF, D_MODEL), D_FF),
        "final_norm": gain(ks[16], (D_MODEL,)),
    }


def reference(x, ffn1_norm, ffn1_w13, ffn1_w2, mix_norm, w_in, forget_bias, pool_w, pool_scale,
              w_branch_pool, w_branch_fox, w_branch_ret, w_out, ffn2_norm, ffn2_w13, ffn2_w2,
              final_norm):
    for l in range(DEPTH):
        x = x + 0.5 * swiglu(rms_norm(x, ffn1_norm[l]), ffn1_w13[l], ffn1_w2[l])
        x = x + hybrid_mixer(rms_norm(x, mix_norm[l]), w_in[l], forget_bias[l], pool_w[l],
                             pool_scale[l], w_branch_pool[l], w_branch_fox[l], w_branch_ret[l],
                             w_out[l])
        x = x + 0.5 * swiglu(rms_norm(x, ffn2_norm[l]), ffn2_w13[l], ffn2_w2[l])
    return rms_norm(x, final_norm)
```

```cpp
#include <hip/hip_runtime.h>
#include <cstdio>
#include <cstdint>
#include <cmath>
namespace pg8 {
#define PG8_LAS __attribute__((address_space(3)))
typedef unsigned short bf16_t;
typedef short bf16x8 __attribute__((ext_vector_type(8)));
typedef float f32x4 __attribute__((ext_vector_type(4)));
typedef unsigned u32x4 __attribute__((ext_vector_type(4)));
constexpr int BM = 256, BK = 64, HALF = 128, HTB = HALF * BK * 2  , STAGE_BYTES = 8 * HTB, NXCD = 8, WGM = 8;

__host__ __device__ __forceinline__ int lds_byte(int r, int c) { const int st = (r >> 4) * 2 + (c >> 5), rr = r & 15, cc = c & 31, ob = rr * 64 + cc * 2; return st * 1024 + (ob ^ (((ob >> 9) & 1) << 5)); }
__host__ __device__ __forceinline__ void stage_rc(int b, int& R, int& C) { const int st = b / 1024, sb = b % 1024, swz = sb ^ (((sb >> 9) & 1) << 5); R = (st >> 1) * 16 + swz / 64; C = (st & 1) * 32 + (swz % 64) / 2; }
__host__ __device__ __forceinline__ int perm32(int rho) { const int n = rho >> 4, i = rho & 15; return 8 * (i >> 2) + 4 * n + (i & 3); }

struct Unit { int pm, pn; };
struct Gemm { const bf16_t* A; const bf16_t* Bt; int M, N, K; };

struct StaticOrder {
    int nM, nN, nwg, G, c;
    __host__ __device__ void init(int M, int N, int G_, int c_) { nM = M / BM; nN = N / BM; nwg = nM * nN; G = G_; c = c_; }
    __host__ __device__ bool next(int i, Unit& u) const {
        const long L = (long)i * G + c; if (L >= nwg) return false;
        int wgid = (int)L; { const int q = nwg / NXCD, r = nwg % NXCD, xcd = wgid % NXCD, off = wgid / NXCD; wgid = (xcd < r ? xcd * (q + 1) : r * (q + 1) + (xcd - r) * q) + off; }
        const int nig = WGM * nN, gid = wgid / nig, fm = gid * WGM, gsz = (nM - fm) < WGM ? (nM - fm) : WGM;
        u.pm = fm + ((wgid % nig) % gsz); u.pn = (wgid % nig) / gsz; return true;
    }
    __device__ __forceinline__ void a_ready(const Unit&) const {}
    __device__ __forceinline__ void done(const Unit&) const {}
};

__device__ __forceinline__ unsigned cvt_pk_bf16(float lo, float hi) { unsigned r; asm volatile("v_cvt_pk_bf16_f32 %0, %1, %2" : "=v"(r) : "v"(lo), "v"(hi)); return r; }
typedef float f32x2 __attribute__((ext_vector_type(2)));
typedef unsigned u32x2v __attribute__((ext_vector_type(2)));
constexpr int DM = 2048;
constexpr float LOG2E = 1.4426950408889634f;
__device__ __forceinline__ float fast_sigmoid(float x) { return __builtin_amdgcn_rcpf(1.0f + __builtin_amdgcn_exp2f(-x * LOG2E)); }
__device__ __forceinline__ float fast_silu(float x) { return x * fast_sigmoid(x); }
__device__ __forceinline__ float gate_sig(float x) { return fmaxf(fast_sigmoid(x), 1e-18f); }
__device__ __forceinline__ u32x4 pack8(const f32x4 a, const f32x4 b) { u32x4 w; w.x = cvt_pk_bf16(a[0], a[1]); w.y = cvt_pk_bf16(a[2], a[3]); w.z = cvt_pk_bf16(b[0], b[1]); w.w = cvt_pk_bf16(b[2], b[3]); return w; }
__device__ __forceinline__ f32x4 bf_lo4(const u32x4 w) { return (f32x4){__uint_as_float(w.x << 16), __uint_as_float(w.x & 0xffff0000u), __uint_as_float(w.y << 16), __uint_as_float(w.y & 0xffff0000u)}; }
__device__ __forceinline__ f32x4 bf_hi4(const u32x4 w) { return (f32x4){__uint_as_float(w.z << 16), __uint_as_float(w.z & 0xffff0000u), __uint_as_float(w.w << 16), __uint_as_float(w.w & 0xffff0000u)}; }
__device__ __forceinline__ float row_rstd(const float* ss, int row) {
    const f32x4 a = *(const f32x4*)(ss + (size_t)row * 8), b = *(const f32x4*)(ss + (size_t)row * 8 + 4);
    const float s = ((a[0] + a[1]) + (a[2] + a[3])) + ((b[0] + b[1]) + (b[2] + b[3]));
    return 1.0f / sqrtf(s * (1.0f / (float)DM) + 1e-6f);
}

struct EpiSwiGLU {
    static constexpr bool PERM = true, AFTER_DRAIN = false, KEEP_ACC = false;
    bf16_t* H; const float* ss; int ldh;
    __device__ __forceinline__ void operator()(const f32x4 (&acc)[2][2][4][2], const Unit& u, int wr, int wc, int fr, int fq) const {
        const int row0 = u.pm * BM + wr * 64 + fr, col0 = u.pn * HALF + wc * 32 + 8 * fq;
#pragma unroll
        for (int ai = 0; ai < 2; ++ai)
#pragma unroll
            for (int m = 0; m < 4; ++m) {
                const int row = row0 + ai * HALF + m * 16; const float rs = row_rstd(ss, row);
                f32x4 h[2];
#pragma unroll
                for (int n = 0; n < 2; ++n) { const f32x4 a = acc[ai][0][m][n] * rs, b = acc[ai][1][m][n] * rs;
                    h[n] = (f32x4){fast_silu(a[0]) * b[0], fast_silu(a[1]) * b[1], fast_silu(a[2]) * b[2], fast_silu(a[3]) * b[3]}; }
                *(u32x4*)(H + (size_t)row * ldh + col0) = pack8(h[0], h[1]);
                asm volatile("" ::: "memory");
            }
    }
};

struct EpiResid {
    static constexpr bool PERM = true, AFTER_DRAIN = true, KEEP_ACC = false;
    const float* xin; float* xout; bf16_t* xb; float* ss; float coef;
    __device__ __forceinline__ void fused(f32x4 (&acc)[2][2][4][2], const Unit& u, int wr, int wc, int fr, int fq, PG8_LAS unsigned char* lds, int wid, int lane) const {
        PG8_LAS float* P = (PG8_LAS float*)lds;
        const int row0 = u.pm * BM + wr * 64 + fr, col0 = u.pn * BM + wc * 32 + 8 * fq;
#pragma unroll
        for (int ai = 0; ai < 2; ++ai)
#pragma unroll
            for (int m = 0; m < 4; ++m) {
                const int row = row0 + ai * HALF + m * 16; float sq = 0.f;
#pragma unroll
                for (int bj = 0; bj < 2; ++bj) { const size_t off = (size_t)row * DM + col0 + bj * HALF;
                    f32x4 v0 = *(const f32x4*)(xin + off), v1 = *(const f32x4*)(xin + off + 4);
                    v0 = v0 + acc[ai][bj][m][0] * coef; v1 = v1 + acc[ai][bj][m][1] * coef;
                    *(f32x4*)(xout + off) = v0; *(f32x4*)(xout + off + 4) = v1; *(u32x4*)(xb + off) = pack8(v0, v1);
                    sq += ((v0[0] * v0[0] + v0[1] * v0[1]) + (v0[2] * v0[2] + v0[3] * v0[3])) + ((v1[0] * v1[0] + v1[1] * v1[1]) + (v1[2] * v1[2] + v1[3] * v1[3])); }
                sq += __shfl_xor(sq, 16); sq += __shfl_xor(sq, 32);
                if (fq == 0) P[(ai * HALF + wr * 64 + m * 16 + fr) * 4 + wc] = sq;
                asm volatile("" ::: "memory");
            }
        asm volatile("s_waitcnt lgkmcnt(0)" ::: "memory"); __builtin_amdgcn_s_barrier(); asm volatile("" ::: "memory");
        const int t = wid * 64 + lane;
        if (t < 256) { const f32x4 p = *(const PG8_LAS f32x4*)(P + t * 4); ss[(size_t)(u.pm * BM + t) * 8 + u.pn] = (p[0] + p[1]) + (p[2] + p[3]); }
        asm volatile("s_waitcnt lgkmcnt(0)" ::: "memory"); __builtin_amdgcn_s_barrier(); asm volatile("" ::: "memory");
    }
};

struct EpiWin {
    static constexpr bool PERM = true, AFTER_DRAIN = false, KEEP_ACC = false;
    const float* ss; bf16_t *U, *FQ, *FK, *FV, *RQ, *RK, *RV, *RG, *GATES; const float *rcos, *rsin;
    __device__ __forceinline__ void operator()(const f32x4 (&acc)[2][2][4][2], const Unit& u, int wr, int wc, int fr, int fq) const {
        const int row0 = u.pm * BM + wr * 64 + fr; const int reg = u.pn >> 2;
        if (reg == 4 || reg == 5) {
            const int head = 2 * (u.pn & 3) + (wc >> 1), j0 = 32 * (wc & 1) + 8 * fq;
            const float lg = log2f(1.0f - exp2f(-5.0f - (float)head));
            bf16_t* dst = (reg == 4) ? RQ : RK;
#pragma unroll
            for (int ai = 0; ai < 2; ++ai)
#pragma unroll
                for (int m = 0; m < 4; ++m) {
                    const int row = row0 + ai * HALF + m * 16, t = row & 2047; const float rs = row_rstd(ss, row);
                    const float sc = rs * ((reg == 4) ? exp2f((float)t * lg) * 0.08838834764831845f : exp2f(-(float)t * lg));
                    f32x4 o1[2], o2[2];
#pragma unroll
                    for (int n = 0; n < 2; ++n) { const f32x4 c = *(const f32x4*)(rcos + t * 64 + j0 + 4 * n), s = *(const f32x4*)(rsin + t * 64 + j0 + 4 * n);
                        const f32x4 x1 = acc[ai][0][m][n] * sc, x2 = acc[ai][1][m][n] * sc; o1[n] = x1 * c - x2 * s; o2[n] = x1 * s + x2 * c; }
                    bf16_t* p = dst + (size_t)row * 1024 + head * 128 + j0;
                    *(u32x4*)p = pack8(o1[0], o1[1]); *(u32x4*)(p + 64) = pack8(o2[0], o2[1]);
                    asm volatile("" ::: "memory");
                }
            return;
        }
        bf16_t* dst; int ldc, colt; int act = 0; float mul = 1.f;
        if (reg < 8) { ldc = 1024; colt = (u.pn & 3) * BM;
            dst = reg == 0 ? U : reg == 1 ? FQ : reg == 2 ? FK : reg == 3 ? FV : reg == 6 ? RV : RG;
            if (reg == 1) mul = 0.08838834764831845f * LOG2E;
            if (reg == 7) act = 1; }
        else { ldc = 6144; colt = (u.pn - 32) * BM; dst = GATES; act = 2; }
        const int col0 = colt + wc * 32 + 8 * fq;
#pragma unroll
        for (int ai = 0; ai < 2; ++ai)
#pragma unroll
            for (int m = 0; m < 4; ++m) {
                const int row = row0 + ai * HALF + m * 16; const float rs = row_rstd(ss, row) * mul;
#pragma unroll
                for (int bj = 0; bj < 2; ++bj) { f32x4 v0 = acc[ai][bj][m][0] * rs, v1 = acc[ai][bj][m][1] * rs;
                    if (act == 1) { v0 = (f32x4){fast_silu(v0[0]), fast_silu(v0[1]), fast_silu(v0[2]), fast_silu(v0[3])}; v1 = (f32x4){fast_silu(v1[0]), fast_silu(v1[1]), fast_silu(v1[2]), fast_silu(v1[3])}; }
                    if (act == 2) { v0 = (f32x4){gate_sig(v0[0]), gate_sig(v0[1]), gate_sig(v0[2]), gate_sig(v0[3])}; v1 = (f32x4){gate_sig(v1[0]), gate_sig(v1[1]), gate_sig(v1[2]), gate_sig(v1[3])}; }
                    *(u32x4*)(dst + (size_t)row * ldc + col0 + bj * HALF) = pack8(v0, v1); }
                asm volatile("" ::: "memory");
            }
    }
};

struct EpiBranch {
    static constexpr bool PERM = true, AFTER_DRAIN = false, KEEP_ACC = true;
    const bf16_t* GATES; bf16_t* MGB;
    __device__ __forceinline__ void operator()(f32x4 (&acc)[2][2][4][2], const Unit& u, int wr, int wc, int fr, int fq) const {
        const int br = u.pm >> 5, pm = u.pm & 31, pn = u.pn & 7;
        const int row0 = pm * BM + wr * 64 + fr, col0 = pn * BM + wc * 32 + 8 * fq;
#pragma unroll
        for (int ai = 0; ai < 2; ++ai)
#pragma unroll
            for (int m = 0; m < 4; ++m) {
                const int row = row0 + ai * HALF + m * 16;
#pragma unroll
                for (int bj = 0; bj < 2; ++bj) { const bf16_t* gp = GATES + (size_t)row * 6144 + br * DM + col0 + bj * HALF;
                    const u32x4 g = *(const u32x4*)gp; f32x4 s0 = bf_lo4(g), s1 = bf_hi4(g);
                    if (br < 2) { const u32x4 gn = *(const u32x4*)(gp + DM); s0 = s0 / bf_lo4(gn); s1 = s1 / bf_hi4(gn);
                        acc[ai][bj][m][0] = acc[ai][bj][m][0] * s0; acc[ai][bj][m][1] = acc[ai][bj][m][1] * s1; }
                    else { *(u32x4*)(MGB + (size_t)row * DM + col0 + bj * HALF) = pack8(acc[ai][bj][m][0] * s0, acc[ai][bj][m][1] * s1);
                        acc[ai][bj][m][0] = (f32x4){0.f, 0.f, 0.f, 0.f}; acc[ai][bj][m][1] = (f32x4){0.f, 0.f, 0.f, 0.f}; } }
                asm volatile("" ::: "memory");
            }
    }
};
struct BranchOrder {
    StaticOrder so;
    __device__ bool next(int i, Unit& u) const { if (i >= 3) return false; Unit t; if (!so.next(0, t)) return false; u.pm = i * 32 + t.pm; u.pn = i * 8 + t.pn; return true; }
    __device__ __forceinline__ void a_ready(const Unit&) const {}
    __device__ __forceinline__ void done(const Unit&) const {}
};

struct EpiFold {
    static constexpr bool PERM = true, AFTER_DRAIN = false, KEEP_ACC = false;
    bf16_t* WBR; size_t layer_stride;
    __device__ __forceinline__ void operator()(const f32x4 (&acc)[2][2][4][2], const Unit& u, int wr, int wc, int fr, int fq) const {
        const int lg = u.pn, l = lg >> 2, g = lg & 3, ob = (u.pm & 7) * BM;
        bf16_t* base = WBR + (size_t)l * layer_stride + g * 256 + wc * 32 + 8 * fq;
#pragma unroll
        for (int ai = 0; ai < 2; ++ai)
#pragma unroll
            for (int m = 0; m < 4; ++m) { const int o = ob + ai * HALF + wr * 64 + m * 16 + fr;
#pragma unroll
                for (int bj = 0; bj < 2; ++bj) *(u32x4*)(base + (size_t)o * 1024 + bj * HALF) = pack8(acc[ai][bj][m][0], acc[ai][bj][m][1]); }
    }
};
struct FoldOrder {
    int c;
    __device__ bool next(int i, Unit& u) const { if (i > 0 || c >= 128) return false; u.pm = c; u.pn = c >> 3; return true; }
    __device__ __forceinline__ void a_ready(const Unit&) const {}
    __device__ __forceinline__ void done(const Unit&) const {}
};

template <class Epi, class Sched, bool ALIGN_EPI = false, bool SP2 = false>
__device__ __forceinline__ void gemm_phase(PG8_LAS unsigned char* lds, const Gemm g, const Sched& S, const Epi& E) {
    int tid_ = threadIdx.x; asm volatile("" : "+v"(tid_));
    const int tid = tid_, wid = __builtin_amdgcn_readfirstlane(tid >> 6), lane = tid & 63, wr = wid >> 2, wc = wid & 3, fr = lane & 15, fq = lane >> 4;
    const int K = g.K, nt = K / BK;
    unsigned voffA[2], voffB[2];
#pragma unroll
    for (int i = 0; i < 2; ++i) { int R, C; stage_rc(tid * 16 + i * 8192, R, C); const int Rb = Epi::PERM ? ((R & ~31) + perm32(R & 31)) : R;
        voffA[i] = (unsigned)(R * K + C) * 2u; voffB[i] = (unsigned)(Rb * K + C) * 2u; }
    const size_t kstep = (size_t)(BK * 2);
    const size_t hstep = (size_t)HALF * K * 2;
    const size_t tstep = 2 * hstep;
    const unsigned ldsw = (unsigned)wid * 1024u;
    const int aoff = lds_byte(wr * 64 + fr, fq * 8), boff = lds_byte(wc * 32 + fr, fq * 8);
#define PG8_SA(b, h) (((b) * 2 + (h)) * HTB)
#define PG8_SB(b, h) ((4 + (b) * 2 + (h)) * HTB)
#define PG8_STAGE(bufoff, gbase, voff) do { _Pragma("unroll") for (int _i = 0; _i < 2; ++_i) \
        __builtin_amdgcn_global_load_lds((const unsigned*)((const char*)(gbase) + (voff)[_i]), (PG8_LAS unsigned*)(lds + (bufoff) + ldsw + _i * 8192), 16, 0, 0); } while (0)
#define PG8_LDA(dst, b, h) do { _Pragma("unroll") for (int m = 0; m < 4; ++m) _Pragma("unroll") for (int k = 0; k < 2; ++k) dst[m][k] = *(const PG8_LAS bf16x8*)(lds + PG8_SA(b, h) + aoff + m * 2048 + k * 1024); } while (0)
#define PG8_LDB(dst, b, h) do { _Pragma("unroll") for (int n = 0; n < 2; ++n) _Pragma("unroll") for (int k = 0; k < 2; ++k) dst[n][k] = *(const PG8_LAS bf16x8*)(lds + PG8_SB(b, h) + boff + n * 2048 + k * 1024); } while (0)
#define PG8_MMA(ai, bj, At, Bt) do { __builtin_amdgcn_s_setprio(1); _Pragma("unroll") for (int m = 0; m < 4; ++m) _Pragma("unroll") for (int n = 0; n < 2; ++n) _Pragma("unroll") for (int k = 0; k < 2; ++k) \
        acc[ai][bj][m][n] = __builtin_amdgcn_mfma_f32_16x16x32_bf16(Bt[n][k], At[m][k], acc[ai][bj][m][n], 0, 0, 0); __builtin_amdgcn_s_setprio(0); } while (0)
#define PG8_WAIT_V(n) asm volatile("s_waitcnt vmcnt(" #n ")" ::: "memory")
#define PG8_WAIT_L(n) asm volatile("s_waitcnt lgkmcnt(" #n ")" ::: "memory")
#define PG8_BAR __builtin_amdgcn_s_barrier()
#define PG8_SCHED __builtin_amdgcn_sched_barrier(0)
    Unit cur, nxt; int ui = 0;
    if (!S.next(0, cur)) return;
    f32x4 acc[2][2][4][2];
#pragma unroll
    for (int a = 0; a < 2; ++a)
#pragma unroll
        for (int b = 0; b < 2; ++b)
#pragma unroll
            for (int m = 0; m < 4; ++m)
#pragma unroll
                for (int n = 0; n < 2; ++n) acc[a][b][m][n] = (f32x4){0.f, 0.f, 0.f, 0.f};
    bf16x8 At[4][2], B0[2][2], B1[2][2];
    const char* cA = (const char*)g.A + (size_t)cur.pm * tstep; const char* cB = (const char*)g.Bt + (size_t)cur.pn * tstep;
    S.a_ready(cur);
    if constexpr (SP2) {
        PG8_STAGE(PG8_SB(0, 0), cB, voffB); PG8_STAGE(PG8_SB(0, 1), cB + hstep, voffB); PG8_STAGE(PG8_SA(0, 0), cA, voffA); PG8_STAGE(PG8_SA(0, 1), cA + hstep, voffA);
        if (wr == 1) PG8_BAR;
        PG8_WAIT_V(2); PG8_BAR;
        PG8_STAGE(PG8_SB(1, 0), cB + kstep, voffB); PG8_STAGE(PG8_SA(1, 0), cA + kstep, voffA); PG8_STAGE(PG8_SB(1, 1), cB + hstep + kstep, voffB);
        PG8_WAIT_V(6); PG8_BAR;
    } else {
        PG8_STAGE(PG8_SB(0, 0), cB, voffB); PG8_STAGE(PG8_SA(0, 0), cA, voffA); PG8_STAGE(PG8_SB(0, 1), cB + hstep, voffB); PG8_STAGE(PG8_SA(0, 1), cA + hstep, voffA);
        if (wr == 1) PG8_BAR;
        PG8_WAIT_V(4); PG8_BAR;
        PG8_STAGE(PG8_SB(1, 0), cB + kstep, voffB); PG8_STAGE(PG8_SA(1, 0), cA + kstep, voffA); PG8_STAGE(PG8_SB(1, 1), cB + hstep + kstep, voffB);
        PG8_WAIT_V(6); PG8_BAR;
    }
    for (;;) {
        const bool has_next = S.next(ui + 1, nxt);
        const char* nA = has_next ? (const char*)g.A + (size_t)nxt.pm * tstep : cA; const char* nB = has_next ? (const char*)g.Bt + (size_t)nxt.pn * tstep : cB;
        for (int t = 0; t < nt; t += 2) {
            const bool last = (t == nt - 2);
            const char* a1 = cA + (size_t)(t + 1) * kstep;
            const char* a2 = last ? nA : cA + (size_t)(t + 2) * kstep; const char* b2 = last ? nB : cB + (size_t)(t + 2) * kstep;
            const char* a3 = a2 + kstep; const char* b3 = b2 + kstep;
            if (last && has_next) S.a_ready(nxt);
            if constexpr (SP2) {
            PG8_LDB(B0, 0, 0); PG8_LDB(B1, 0, 1); PG8_SCHED; PG8_LDA(At, 0, 0); PG8_STAGE(PG8_SA(1, 1), a1 + hstep, voffA);
            PG8_WAIT_V(8); PG8_WAIT_L(0); PG8_BAR; PG8_MMA(0, 0, At, B0); PG8_MMA(0, 1, At, B1); PG8_BAR; PG8_SCHED;
            PG8_LDA(At, 0, 1); PG8_STAGE(PG8_SB(0, 0), b2, voffB); PG8_STAGE(PG8_SB(0, 1), b2 + hstep, voffB); PG8_STAGE(PG8_SA(0, 0), a2, voffA);
            PG8_WAIT_V(8); PG8_WAIT_L(0); PG8_BAR; PG8_MMA(1, 0, At, B0); PG8_MMA(1, 1, At, B1); PG8_BAR; PG8_SCHED;
            PG8_LDB(B0, 1, 0); PG8_LDB(B1, 1, 1); PG8_SCHED; PG8_LDA(At, 1, 0); PG8_STAGE(PG8_SA(0, 1), a2 + hstep, voffA);
            PG8_WAIT_V(8); PG8_WAIT_L(0); PG8_BAR; PG8_MMA(0, 0, At, B0); PG8_MMA(0, 1, At, B1); PG8_BAR; PG8_SCHED;
            PG8_LDA(At, 1, 1); PG8_STAGE(PG8_SB(1, 0), b3, voffB); PG8_STAGE(PG8_SB(1, 1), b3 + hstep, voffB); PG8_STAGE(PG8_SA(1, 0), a3, voffA);
            PG8_WAIT_V(8); PG8_WAIT_L(0); PG8_BAR; PG8_MMA(1, 0, At, B0); PG8_MMA(1, 1, At, B1); PG8_BAR; PG8_SCHED;
            } else {
            PG8_LDB(B0, 0, 0); PG8_SCHED; PG8_LDA(At, 0, 0); PG8_STAGE(PG8_SA(1, 1), a1 + hstep, voffA);
            PG8_WAIT_L(8); PG8_BAR; PG8_WAIT_L(0); PG8_MMA(0, 0, At, B0); PG8_BAR; PG8_SCHED;
            PG8_LDB(B1, 0, 1); PG8_STAGE(PG8_SB(0, 0), b2, voffB);
            PG8_BAR; PG8_WAIT_L(0); PG8_MMA(0, 1, At, B1); PG8_BAR;
            PG8_LDA(At, 0, 1); PG8_STAGE(PG8_SA(0, 0), a2, voffA);
            PG8_BAR; PG8_WAIT_L(0); PG8_MMA(1, 0, At, B0); PG8_BAR; PG8_SCHED;
            PG8_STAGE(PG8_SB(0, 1), b2 + hstep, voffB);
            PG8_WAIT_V(6); PG8_BAR; PG8_MMA(1, 1, At, B1); PG8_BAR;
            PG8_LDB(B0, 1, 0); PG8_SCHED; PG8_LDA(At, 1, 0); PG8_STAGE(PG8_SA(0, 1), a2 + hstep, voffA);
            PG8_WAIT_L(8); PG8_BAR; PG8_WAIT_L(0); PG8_MMA(0, 0, At, B0); PG8_BAR; PG8_SCHED;
            PG8_LDB(B1, 1, 1); PG8_STAGE(PG8_SB(1, 0), b3, voffB);
            PG8_BAR; PG8_WAIT_L(0); PG8_MMA(0, 1, At, B1); PG8_BAR;
            PG8_LDA(At, 1, 1); PG8_STAGE(PG8_SA(1, 0), a3, voffA);
            PG8_BAR; PG8_WAIT_L(0); PG8_MMA(1, 0, At, B0); PG8_BAR; PG8_SCHED;
            PG8_STAGE(PG8_SB(1, 1), b3 + hstep, voffB);
            PG8_WAIT_V(6); PG8_BAR; PG8_MMA(1, 1, At, B1); PG8_BAR;
            }
        }
        if constexpr (ALIGN_EPI) { if (wr == 0) PG8_BAR; }
        if constexpr (!Epi::AFTER_DRAIN) { E(acc, cur, wr, wc, fr, fq); S.done(cur); }
        if (!has_next) break;
        if constexpr (!Epi::KEEP_ACC) {
#pragma unroll
        for (int a = 0; a < 2; ++a)
#pragma unroll
            for (int b = 0; b < 2; ++b)
#pragma unroll
                for (int m = 0; m < 4; ++m)
#pragma unroll
                    for (int n = 0; n < 2; ++n) acc[a][b][m][n] = (f32x4){0.f, 0.f, 0.f, 0.f};
        }
        cur = nxt; cA = nA; cB = nB; ++ui;
        if constexpr (ALIGN_EPI) { if (wr == 1) PG8_BAR; }
    }
    PG8_WAIT_V(0);
    if constexpr (!ALIGN_EPI) { if (wr == 0) PG8_BAR; }
    PG8_BAR;
    if constexpr (Epi::AFTER_DRAIN) { E.fused(acc, cur, wr, wc, fr, fq, lds, wid, lane); S.done(cur); }
#undef PG8_SA
#undef PG8_SB
#undef PG8_STAGE
#undef PG8_LDA
#undef PG8_LDB
#undef PG8_MMA
#undef PG8_WAIT_V
#undef PG8_WAIT_L
#undef PG8_BAR
#undef PG8_SCHED
}
}

constexpr int NWAVES = 8;
constexpr int BATCH = 4, SEQ = 2048, D = 2048, DEPTH = 4, M = BATCH * SEQ;
constexpr int DFF = 5632, NH = 8, HD = 128, WIDE = 1024;
constexpr int IN_W = 14344, WIN_N = 14336;
constexpr int SRC_FQ = 1024, SRC_FLOGIT = 4096, SRC_RQ = 4104, SRC_RK = 5128, SRC_RV = 6152, SRC_RG = 7176, SRC_GATES = 8200;
#ifndef MK_PER_PHASE
#define MK_PER_PHASE 0
#endif
constexpr int N_PHASES = 2 + 8 * 2 + 4 * 4 + 1;

constexpr size_t MiB = 1u << 20;
constexpr size_t WS_CTL = 0, CTL_ZERO_BYTES = 1 * MiB;
constexpr size_t WS_WF = 1 * MiB;
constexpr size_t WS_COS = 2 * MiB, WS_SIN = 2 * MiB + 512 * 1024;
constexpr size_t WS_SS = 3 * MiB;
constexpr size_t WS_FL = 3 * MiB + 512 * 1024;
constexpr size_t WS_WP = 4 * MiB;
constexpr size_t WS_WBPT = 6 * MiB;
constexpr size_t WS_W13T = 32 * MiB,  SZ_W13T = (size_t)2 * DFF * D * 2;
constexpr size_t WS_W2T = WS_W13T + 8 * SZ_W13T, SZ_W2T = (size_t)D * DFF * 2;
constexpr size_t WS_WINT = WS_W2T + 8 * SZ_W2T, SZ_WINT = (size_t)WIN_N * D * 2;
constexpr size_t WS_WBR = WS_WINT + 4 * SZ_WINT, SZ_WBR = (size_t)3 * D * WIDE * 2;
constexpr size_t WS_WOUT = WS_WBR + 4 * SZ_WBR, SZ_WOUT = (size_t)D * D * 2;
constexpr size_t WS_X = WS_WOUT + 4 * SZ_WOUT;
constexpr size_t WS_XB = WS_X + (size_t)M * D * 4;
constexpr size_t WS_H = WS_XB + (size_t)M * D * 2;
constexpr size_t SZ_ACT = (size_t)M * WIDE * 2;
constexpr size_t WS_U = WS_H + (size_t)M * DFF * 2;
constexpr size_t WS_FQ = WS_U + SZ_ACT, WS_FK = WS_FQ + SZ_ACT, WS_FV = WS_FK + SZ_ACT, WS_RQ = WS_FV + SZ_ACT, WS_RK = WS_RQ + SZ_ACT, WS_RV = WS_RK + SZ_ACT, WS_RG = WS_RV + SZ_ACT;
constexpr size_t WS_GATES = WS_RG + SZ_ACT;
constexpr size_t WS_BRA = WS_GATES + (size_t)M * 6144 * 2;
constexpr size_t WS_MG = WS_BRA + 3 * SZ_ACT;
constexpr size_t WS_MGB = WS_MG + (size_t)M * D * 4;
constexpr size_t WS_END = WS_MGB + (size_t)M * D * 2;
static_assert(WS_W13T % 256 == 0 && SZ_W13T % 256 == 0 && SZ_W2T % 256 == 0 && SZ_WINT % 256 == 0 && WS_X % 256 == 0 && WS_END < (size_t)1700 * MiB, "d_ws map");
constexpr int CW_TMO = 0, CW_CODE = 1;
constexpr int CW_QUEUE = 64;
constexpr int CW_BAR = 4096;
constexpr int RING_OFF = 0, RING_BYTES = 131072;
constexpr int LDSCTL_OFF = RING_BYTES, MISC_OFF = LDSCTL_OFF + 320;
constexpr int LDS_BYTES = 147456;
static_assert(MISC_OFF + 128 <= LDS_BYTES, "LDS map");

#define GAS __attribute__((address_space(1)))
#define LAS __attribute__((address_space(3)))
typedef unsigned short bf16;
typedef unsigned v4u __attribute__((ext_vector_type(4)));
typedef unsigned v2u __attribute__((ext_vector_type(2)));
typedef float f32x4 __attribute__((ext_vector_type(4)));
typedef float f32x16 __attribute__((ext_vector_type(16)));
typedef short bf16x8 __attribute__((ext_vector_type(8)));
typedef short s16x4 __attribute__((ext_vector_type(4)));
typedef GAS unsigned gu32;
#define RLX_AGENT __ATOMIC_RELAXED, __HIP_MEMORY_SCOPE_AGENT
#define LDS_WAIT() asm volatile("s_waitcnt lgkmcnt(0)" ::: "memory")
#define VM_WAIT() asm volatile("s_waitcnt vmcnt(0)" ::: "memory")
__device__ __forceinline__ unsigned f2bf(float f) { unsigned u = __builtin_bit_cast(unsigned, f); return (u + 0x7fffu + ((u >> 16) & 1u)) >> 16; }
__device__ __forceinline__ unsigned pk2(float lo, float hi) { return f2bf(lo) | (f2bf(hi) << 16); }
__device__ __forceinline__ float bf2f(unsigned short h) { return __uint_as_float((unsigned)h << 16); }

#define XB_TMO      128
#define XB_XCNT(j)  (256  + 64 * (j))
#define XB_XSUB(j)  (1280 + 64 * (j))
#define XB_XGEN(j)  (2304 + 64 * (j))
#define XB_TOP      3328
#define XB_TOPGEN   3392
#define XCD_BAR_WORDS 3456
#define XB_SPIN_CAP (1u << 18)

__device__ __forceinline__ unsigned xb_ld(unsigned* p)              { return __hip_atomic_load(p, __ATOMIC_RELAXED, __HIP_MEMORY_SCOPE_AGENT); }
__device__ __forceinline__ unsigned xb_add(unsigned* p, unsigned v) { return __hip_atomic_fetch_add(p, v, __ATOMIC_RELAXED, __HIP_MEMORY_SCOPE_AGENT); }
__device__ __forceinline__ unsigned xb_xcc_id() { return (unsigned)__builtin_amdgcn_s_getreg((3 << 11) | 20) & 0xFu; }
#define XB_SPIN(cond, bar) do { unsigned _sp = 0; while (cond) { __builtin_amdgcn_s_sleep(1); \
    if ((++_sp & 255u) == 0u) { if (xb_ld(&(bar)[XB_TMO])) break; if (_sp > XB_SPIN_CAP) { atomicAdd(&(bar)[XB_TMO], 1u); break; } } } } while (0)

struct XcdBarrier {
    unsigned* bar; unsigned x;
    volatile LAS unsigned* st;
};

__device__ __forceinline__ XcdBarrier xcd_barrier_post(unsigned* bar, volatile LAS unsigned* st) {
    XcdBarrier b; b.bar = bar; b.x = xb_xcc_id(); b.st = st;
    if (threadIdx.x == 0) (void)xb_add(&bar[XB_XCNT(b.x)], 1u);
    return b;
}
__device__ __forceinline__ void xcd_barrier_complete(unsigned* bar, unsigned x, unsigned& nloc, unsigned& nx) {
    const unsigned G = gridDim.x * gridDim.y * gridDim.z;
    unsigned sum, cnt, mine, sp = 0u;
    for (;;) {
        sum = 0u; cnt = 0u; mine = 0u;
#pragma unroll
        for (unsigned j = 0; j < 16; ++j) { const unsigned c = xb_ld(&bar[XB_XCNT(j)]); sum += c; cnt += (c > 0u) ? 1u : 0u; mine = (j == x) ? c : mine; }
        if (sum == G) break;
        __builtin_amdgcn_s_sleep(1);
        if ((++sp & 255u) == 0u) { if (xb_ld(&bar[XB_TMO])) break; if (sp > XB_SPIN_CAP) { atomicAdd(&bar[XB_TMO], 1u); break; } }
    }
    nloc = mine > 0u ? mine : 1u; nx = cnt > 0u ? cnt : 1u;
}

__device__ __forceinline__ void xcd_barrier(const XcdBarrier& b) {
    asm volatile("s_waitcnt vmcnt(0)" ::: "memory");
    __syncthreads();
    if (threadIdx.x == 0) {
        unsigned* bar = b.bar;
        __builtin_amdgcn_s_waitcnt(0);
        unsigned nloc = b.st[0], nx = b.st[1];
        if (nloc == 0u) { xcd_barrier_complete(bar, b.x, nloc, nx); b.st[0] = nloc; b.st[1] = nx; }
        const unsigned old = xb_add(&bar[XB_XSUB(b.x)], 1u);
        const unsigned gen = old / nloc;
        if (old + 1u == (gen + 1u) * nloc) {
            __builtin_amdgcn_fence(__ATOMIC_RELEASE, "agent");
            asm volatile("s_waitcnt vmcnt(0)" ::: "memory");
            const unsigned og = xb_add(&bar[XB_TOP], 1u);
            const unsigned tg = og / nx;
            if (og + 1u == (tg + 1u) * nx) xb_add(&bar[XB_TOPGEN], 1u);
            else XB_SPIN(xb_ld(&bar[XB_TOPGEN]) == tg, bar);
            __builtin_amdgcn_fence(__ATOMIC_ACQUIRE, "agent");
            xb_add(&bar[XB_XGEN(b.x)], 1u);
            asm volatile("s_waitcnt vmcnt(0)" ::: "memory");
        } else {
            XB_SPIN(xb_ld(&bar[XB_XGEN(b.x)]) == gen, bar);
            __builtin_amdgcn_fence(__ATOMIC_ACQUIRE, "agent");
            asm volatile("s_waitcnt vmcnt(0)" ::: "memory");
        }
    }
    __syncthreads();
}

struct Args {
    const float* in[17];
    float* out; unsigned char* ws;
    int ph_lo, ph_hi, li, pad;
};
enum { I_X = 0, I_F1N, I_F1W13, I_F1W2, I_MIXN, I_WIN, I_FB, I_POOLW, I_POOLS, I_WBP, I_WBF, I_WBRT, I_WOUT, I_F2N, I_F2W13, I_F2W2, I_FINN };

__device__ __forceinline__ float wave_sum(float v) {
#pragma unroll
    for (int o = 1; o < 64; o <<= 1) v += __shfl_xor(v, o);
    return v;
}

struct TrItem { const float* p; const float* gain; bf16* dst0; size_t ldsrc, ldd; };
__device__ __forceinline__ void tr_load(const TrItem& t, float (&va)[32], float (&vb)[32], float& gv, int lane) {
#pragma unroll
    for (int i = 0; i < 32; ++i) { va[i] = t.p[(size_t)(2 * i) * t.ldsrc]; vb[i] = t.p[(size_t)(2 * i) * t.ldsrc + 32]; }
    gv = t.gain ? t.gain[lane] : 1.0f;
}
__device__ __forceinline__ void tr_store(const TrItem& t, const float (&va)[32], const float (&vb)[32], float gv, LAS float* scr, int lane) {
    const int c = lane & 7;
#pragma unroll
    for (int hh = 0; hh < 2; ++hh) {
#pragma unroll
        for (int i = 0; i < 32; ++i) { const float g0 = __builtin_bit_cast(float, __builtin_amdgcn_readlane(__builtin_bit_cast(int, gv), 2 * i)), g1 = __builtin_bit_cast(float, __builtin_amdgcn_readlane(__builtin_bit_cast(int, gv), 2 * i + 1));
            scr[(2 * i + (lane >> 5)) * 33 + (lane & 31)] = (hh ? vb[i] : va[i]) * ((lane >> 5) ? g1 : g0); }
        LDS_WAIT(); asm volatile("" ::: "memory");
#pragma unroll
        for (int j = 0; j < 4; ++j) { const int n = (lane >> 3) + 8 * j; const LAS float* s = scr + (8 * c) * 33 + n;
            v4u o; o.x = pk2(s[0 * 33], s[1 * 33]); o.y = pk2(s[2 * 33], s[3 * 33]); o.z = pk2(s[4 * 33], s[5 * 33]); o.w = pk2(s[6 * 33], s[7 * 33]);
            *(GAS v4u*)(t.dst0 + (size_t)(32 * hh + n) * t.ldd + 8 * c) = o; }
        LDS_WAIT(); asm volatile("" ::: "memory");
    }
}
__device__ __forceinline__ int win_src_col(int d0) {
    const int reg = d0 >> 10, w = d0 & 1023;
    if (reg < 4) return d0;
    if (reg == 4 || reg == 5) { const int pu = w >> 8, c = w & 255, head = 2 * pu + ((c & 127) >> 6), d = (c >> 7) * 64 + (c & 63); return (reg == 4 ? SRC_RQ : SRC_RK) + head * 128 + d; }
    if (reg == 6) return SRC_RV + w;
    if (reg == 7) return SRC_RG + w;
    return SRC_GATES + (d0 - 8192);
}
__device__ __forceinline__ void sincos_red(float a, float& sn, float& cs) {
    const double x = (double)a; const double q = __builtin_rint(x * 0.6366197723675814); const int n = (int)q;
    const float r = (float)(x - q * 1.5707963267948966), r2 = r * r;
    const float s = r + r * r2 * (-1.6666654611e-1f + r2 * (8.3321608736e-3f + r2 * (-1.9515295891e-4f)));
    const float c = 1.0f - 0.5f * r2 + r2 * r2 * (4.166664568298827e-2f + r2 * (-1.388731625493765e-3f + r2 * 2.443315711809948e-5f));
    switch (n & 3) { case 0: sn = s; cs = c; break; case 1: sn = c; cs = -s; break; case 2: sn = -s; cs = -c; break; default: sn = -c; cs = s; break; }
}


__device__ __forceinline__ void p0_prologue(const Args& args, LAS unsigned char* lds, int wave, int lane, int tid, int G) {
    unsigned char* ws = args.ws;
    LAS float* scr = (LAS float*)(lds + RING_OFF + wave * 16384);
    const int gw = (int)blockIdx.x * NWAVES + wave, NGW = G * NWAVES;
    constexpr int I_W13 = 32 * 176, I_W2 = 88 * 32, I_IN = 32 * 224, I_BR = 16 * 32, I_OUT = 32 * 32;
    constexpr int I_LAYER = 2 * I_W13 + 2 * I_W2 + I_IN + 3 * I_BR + I_OUT, I_ALL = DEPTH * I_LAYER;
#define TR_DECODE(it, T) do { \
        const int l = (it) / I_LAYER; int r = (it) % I_LAYER; \
        const float* src; size_t ldsrc; int k0, s0; const float* gain = nullptr; bf16* dst0; size_t ldd; \
        if (r < 2 * I_W13) { \
            const int f = r / I_W13; r %= I_W13; const int kb = r / 176, db = r % 176, d0 = 64 * db, pn = d0 >> 8, w = d0 & 255; \
            src = (f ? args.in[I_F2W13] : args.in[I_F1W13]) + (size_t)l * D * 2 * DFF; ldsrc = 2 * DFF; k0 = 64 * kb; s0 = (w >> 7) * DFF + pn * 128 + (w & 127); \
            gain = (f ? args.in[I_F2N] : args.in[I_F1N]) + l * D; dst0 = (bf16*)(ws + WS_W13T + (size_t)(2 * l + f) * SZ_W13T) + (size_t)d0 * D + k0; ldd = D; \
        } else if ((r -= 2 * I_W13) < 2 * I_W2) { \
            const int f = r / I_W2; r %= I_W2; const int kb = r / 32, db = r % 32; \
            src = (f ? args.in[I_F2W2] : args.in[I_F1W2]) + (size_t)l * DFF * D; ldsrc = D; k0 = 64 * kb; s0 = 64 * db; \
            dst0 = (bf16*)(ws + WS_W2T + (size_t)(2 * l + f) * SZ_W2T) + (size_t)s0 * DFF + k0; ldd = DFF; \
        } else if ((r -= 2 * I_W2) < I_IN) { \
            const int kb = r / 224, db = r % 224, d0 = 64 * db; \
            src = args.in[I_WIN] + (size_t)l * D * IN_W; ldsrc = IN_W; k0 = 64 * kb; s0 = win_src_col(d0); gain = args.in[I_MIXN] + l * D; \
            dst0 = (bf16*)(ws + WS_WINT + (size_t)l * SZ_WINT) + (size_t)d0 * D + k0; ldd = D; \
        } else if ((r -= I_IN) < 3 * I_BR) { \
            const int br = r / I_BR; r %= I_BR; const int kb = r / 32, db = r % 32; k0 = 64 * kb; s0 = 64 * db; ldsrc = D; \
            src = (br == 0 ? args.in[I_WBP] : br == 1 ? args.in[I_WBF] : args.in[I_WBRT]) + (size_t)l * WIDE * D; \
            if (br == 0) { gain = args.in[I_POOLS] + l * WIDE; \
                dst0 = (bf16*)(ws + WS_WBPT) + ((size_t)(l * 4 + (k0 >> 8)) * D + s0) * 256 + (k0 & 255); ldd = 256; } \
            else { dst0 = (bf16*)(ws + WS_WBR + (size_t)l * SZ_WBR) + (size_t)br * D * WIDE + (size_t)s0 * WIDE + k0; ldd = WIDE; } \
        } else { r -= 3 * I_BR; \
            const int kb = r / 32, db = r % 32; k0 = 64 * kb; s0 = 64 * db; ldsrc = D; \
            src = args.in[I_WOUT] + (size_t)l * D * D; dst0 = (bf16*)(ws + WS_WOUT + (size_t)l * SZ_WOUT) + (size_t)s0 * D + k0; ldd = D; \
        } \
        (T).p = src + (size_t)(k0 + (lane >> 5)) * ldsrc + s0 + (lane & 31); (T).gain = gain ? gain + k0 : nullptr; (T).dst0 = dst0; (T).ldsrc = ldsrc; (T).ldd = ldd; } while (0)
    {
        float vaA[32], vbA[32], vaB[32], vbB[32]; float gvA = 1.f, gvB = 1.f; TrItem tA, tB;
        int it = gw;
        if (it < I_ALL) { TR_DECODE(it, tA); tr_load(tA, vaA, vbA, gvA, lane); }
        for (; it < I_ALL; it += 2 * NGW) {
            const bool hasB = it + NGW < I_ALL, hasA2 = it + 2 * NGW < I_ALL;
            if (hasB) { TR_DECODE(it + NGW, tB); tr_load(tB, vaB, vbB, gvB, lane); }
            tr_store(tA, vaA, vbA, gvA, scr, lane);
            if (hasA2) { TR_DECODE(it + 2 * NGW, tA); tr_load(tA, vaA, vbA, gvA, lane); }
            if (hasB) tr_store(tB, vaB, vbB, gvB, scr, lane);
        }
    }
#undef TR_DECODE
    for (int m = gw; m < M; m += NGW) {
        const GAS f32x4* xr = (const GAS f32x4*)(args.in[I_X] + (size_t)m * D) + lane;
        GAS v2u* o8 = (GAS v2u*)((bf16*)(ws + WS_XB) + (size_t)m * D) + lane; float s = 0.f;
#pragma unroll
        for (int j = 0; j < 8; ++j) { const f32x4 v = xr[64 * j]; s += (v.x * v.x + v.y * v.y) + (v.z * v.z + v.w * v.w); v2u w; w.x = pk2(v.x, v.y); w.y = pk2(v.z, v.w); o8[64 * j] = w; }
        s = wave_sum(s);
        if (lane < 8) ((float*)(ws + WS_SS))[(size_t)m * 8 + lane] = lane == 0 ? s : 0.f;
    }
    const int gt = (int)blockIdx.x * (NWAVES * 64) + tid, NGT = G * NWAVES * 64;
    for (int i = gt; i < SEQ * 64; i += NGT) {
        const int t = i >> 6, j = i & 63; const float inv = powf(10000.0f, -(float)j / 64.0f); float sn, cs; sincos_red((float)t * inv, sn, cs);
        ((float*)(ws + WS_COS))[i] = cs; ((float*)(ws + WS_SIN))[i] = sn; }
    for (int i = gt; i < DEPTH * 4 * 256 * 256; i += NGT) ((bf16*)(ws + WS_WP))[i] = (bf16)f2bf(args.in[I_POOLW][i]);
    for (int i = gt; i < DEPTH * 8 * D; i += NGT) {
        const int l = i / (8 * D), h = (i / D) & 7, k = i % D;
        ((float*)(ws + WS_WF))[i] = args.in[I_WIN][(size_t)l * D * IN_W + (size_t)k * IN_W + SRC_FLOGIT + h] * args.in[I_MIXN][l * D + k]; }
}

__device__ __forceinline__ void flogit_rows(unsigned char* ws, int l, int wave, int lane) {
    const float* X = (const float*)(ws + WS_X); const float* WF = (const float*)(ws + WS_WF) + (size_t)l * 8 * D; const float* ss = (const float*)(ws + WS_SS); float* FL = (float*)(ws + WS_FL);
    const int row0 = (int)blockIdx.x * 32 + wave * 4;
    float acc[4][8];
#pragma unroll
    for (int r = 0; r < 4; ++r)
#pragma unroll
        for (int h = 0; h < 8; ++h) acc[r][h] = 0.f;
#pragma unroll 2
    for (int j = 0; j < 8; ++j) {
        f32x4 wv[8], xv[4];
#pragma unroll
        for (int h = 0; h < 8; ++h) wv[h] = *(const f32x4*)(WF + h * D + 256 * j + 4 * lane);
#pragma unroll
        for (int r = 0; r < 4; ++r) xv[r] = *(const f32x4*)(X + (size_t)(row0 + r) * D + 256 * j + 4 * lane);
#pragma unroll
        for (int r = 0; r < 4; ++r)
#pragma unroll
            for (int h = 0; h < 8; ++h) acc[r][h] += (xv[r].x * wv[h].x + xv[r].y * wv[h].y) + (xv[r].z * wv[h].z + xv[r].w * wv[h].w);
    }
#pragma unroll
    for (int r = 0; r < 4; ++r) { const float rs = pg8::row_rstd(ss, row0 + r);
#pragma unroll
        for (int h = 0; h < 8; ++h) { const float s = wave_sum(acc[r][h]); if (lane == h) FL[(size_t)(row0 + r) * 8 + h] = s * rs; } }
}

__device__ __forceinline__ unsigned off_a(unsigned row, unsigned ch) { return 2048u * (row >> 3) + 512u * (ch >> 2) + 64u * (row & 7u) + 16u * ((ch & 3u) ^ ((row >> 2) & 3u)); }
typedef short v4i16_t __attribute__((ext_vector_type(4)));
__device__ __forceinline__ s16x4 vtr(const LAS unsigned char* p) { return __builtin_bit_cast(s16x4, __builtin_amdgcn_ds_read_tr16_b64_v4i16((LAS v4i16_t*)p)); }
__device__ __forceinline__ int crow(int r, int hi) { return (r & 3) + 8 * (r >> 2) + 4 * hi; }
constexpr int AT_HALF = 65536, AT_K0 = 0, AT_V0 = 32768;
constexpr int AT_NLB = LDSCTL_OFF + 1024, AT_WTOT = AT_NLB + 8192;
static_assert(AT_WTOT + 64 <= LDS_BYTES, "mixer LDS map");
constexpr float LOG2E_F = 1.4426950408889634f;

__device__ __forceinline__ void mix_nlb(unsigned char* ws, const float* fbias_l, LAS unsigned char* lds, int b, int h, int wave, int lane, int tid) {
    LAS float* nlb = (LAS float*)(lds + AT_NLB);
    __syncthreads();
    {
        const float* FL = (const float*)(ws + WS_FL) + (size_t)b * SEQ * 8 + h; const float fb = fbias_l[h];
        float v[4]; float s = 0.f;
#pragma unroll
        for (int e = 0; e < 4; ++e) { const float z = FL[(size_t)(4 * tid + e) * 8] + fb; v[e] = (fminf(z, 0.f) - log1pf(expf(-fabsf(z)))) * LOG2E_F; s += v[e]; }
        float sc = s;
#pragma unroll
        for (int o = 1; o < 64; o <<= 1) { const float t = __shfl_up(sc, o); if (lane >= o) sc += t; }
        LAS float* wtot = (LAS float*)(lds + AT_WTOT);
        if (lane == 63) wtot[wave] = sc;
        __syncthreads();
        float pre = 0.f;
        for (int w = 0; w < wave; ++w) pre += wtot[w];
        float run = pre + (sc - s);
#pragma unroll
        for (int e = 0; e < 4; ++e) { run += v[e]; nlb[4 * tid + e] = -run; }
    }
}
template <int MODE>
__device__ __forceinline__ void mix_half(unsigned char* ws, LAS unsigned char* lds_all, int b, int h, int qb, int wave, int lane) {
    LAS unsigned char* lds = lds_all + MODE * AT_HALF;
    const LAS float* nlb = (const LAS float*)(lds_all + AT_NLB);
    const int q = lane & 31, hi = lane >> 5;
    const int R0 = 128 * qb + 32 * wave, tq = R0 + q;
    const size_t rowbase = (size_t)b * SEQ;
    const bf16* Qg = (const bf16*)(ws + (MODE ? WS_RQ : WS_FQ)) + (rowbase + tq) * WIDE + h * HD;
    const bf16* Kg = (const bf16*)(ws + (MODE ? WS_RK : WS_FK)) + rowbase * WIDE + h * HD;
    const bf16* Vg = (const bf16*)(ws + (MODE ? WS_RV : WS_FV)) + rowbase * WIDE + h * HD;
    const int nt = 2 * (qb + 1);
    bf16x8 qf[8];
#pragma unroll
    for (int s = 0; s < 8; ++s) qf[s] = *(const bf16x8*)(Qg + 16 * s + 8 * hi);
    f32x16 o[4];
#pragma unroll
    for (int c = 0; c < 4; ++c)
#pragma unroll
        for (int r = 0; r < 16; ++r) o[c][r] = 0.f;
    float mrun = -1e30f, lrun = 0.f;
    unsigned stoff0;
    { const unsigned p = (unsigned)(wave * 64 + lane), row = ((p >> 7) << 3) | ((p >> 2) & 7u), ch = (((p >> 5) & 3u) << 2) | ((p & 3u) ^ ((row >> 2) & 3u)); stoff0 = row * WIDE + ch * 8u; }
#define AT_STAGE(jt, buf) do { _Pragma("unroll") for (int _i = 0; _i < 4; ++_i) { \
        __builtin_amdgcn_global_load_lds((const unsigned*)(Kg + (size_t)(64 * (jt) + 16 * _i) * WIDE + stoff0), (LAS unsigned*)(lds + AT_K0 + (buf) * 16384 + (4 * _i + wave) * 1024), 16, 0, 0); \
        __builtin_amdgcn_global_load_lds((const unsigned*)(Vg + (size_t)(64 * (jt) + 16 * _i) * WIDE + stoff0), (LAS unsigned*)(lds + AT_V0 + (buf) * 16384 + (4 * _i + wave) * 1024), 16, 0, 0); } } while (0)
    AT_STAGE(nt - 1, 0);
    asm volatile("s_waitcnt vmcnt(0)" ::: "memory");
    __syncthreads();
    unsigned kbase[2], vbase[2];
#pragma unroll
    for (int e = 0; e < 2; ++e) { kbase[e] = 2048u * ((unsigned)q >> 3) + 64u * ((unsigned)q & 7u) + 16u * ((unsigned)(2 * e + hi) ^ (((unsigned)q >> 2) & 3u)); }
    const unsigned tq_ = (unsigned)(lane & 15) >> 2, tp = (unsigned)lane & 3u, tblk = ((unsigned)lane >> 4) & 1u;
#pragma unroll
    for (int t = 0; t < 2; ++t) vbase[t] = 64u * (4u * hi + tq_) + 16u * ((2u * tblk + (tp >> 1)) ^ ((unsigned)(2 * t + hi) & 3u)) + 8u * (tp & 1u);
    for (int j = 0; j < nt; ++j) {
        const int cur = j & 1, jt = nt - 1 - j; const bool more = (j + 1 < nt);
        if (more) AT_STAGE(jt - 1, cur ^ 1);
        const bool active = (64 * jt <= R0 + 31);
        if (active) {
            const LAS unsigned char* Kt = lds + AT_K0 + cur * 16384; const LAS unsigned char* Vt = lds + AT_V0 + cur * 16384;
            f32x16 s0, s1;
            if (MODE == 0) {
#pragma unroll
                for (int g = 0; g < 4; ++g) { const f32x4 a = *(const LAS f32x4*)(nlb + 64 * jt + 8 * g + 4 * hi), c = *(const LAS f32x4*)(nlb + 64 * jt + 32 + 8 * g + 4 * hi);
#pragma unroll
                    for (int e = 0; e < 4; ++e) { s0[4 * g + e] = a[e]; s1[4 * g + e] = c[e]; } }
            } else {
#pragma unroll
                for (int r = 0; r < 16; ++r) { s0[r] = 0.f; s1[r] = 0.f; }
            }
            {
                bf16x8 kf[16];
#pragma unroll
                for (int s = 0; s < 8; ++s) { const unsigned a = kbase[s & 1] + 512u * (unsigned)(s >> 1);
                    kf[2 * s] = *(const LAS bf16x8*)(Kt + a); kf[2 * s + 1] = *(const LAS bf16x8*)(Kt + a + 8192); }
                __builtin_amdgcn_sched_barrier(0);
#pragma unroll
                for (int s = 0; s < 8; ++s) {
                    s0 = __builtin_amdgcn_mfma_f32_32x32x16_bf16(kf[2 * s], qf[s], s0, 0, 0, 0);
                    s1 = __builtin_amdgcn_mfma_f32_32x32x16_bf16(kf[2 * s + 1], qf[s], s1, 0, 0, 0);
                }
            }
            s16x4 vv[4][2][2][2];
#pragma unroll
            for (int c = 0; c < 2; ++c)
#pragma unroll
                for (int blk = 0; blk < 2; ++blk)
#pragma unroll
                    for (int st = 0; st < 2; ++st)
#pragma unroll
                        for (int t = 0; t < 2; ++t) vv[c][blk][st][t] = vtr(Vt + vbase[t] + 2048u * (unsigned)(4 * blk + 2 * st + t) + 512u * (unsigned)c);
            __builtin_amdgcn_sched_barrier(0);
            if (64 * jt + 63 > R0) {
                const float NEG = MODE == 0 ? -__builtin_inff() : 0.f;
#pragma unroll
                for (int r = 0; r < 16; ++r) { const int key = 64 * jt + crow(r, hi); if (key > tq) s0[r] = NEG; if (key + 32 > tq) s1[r] = NEG; }
            }
            if (MODE == 0) {
                float pmax = s0[0];
#pragma unroll
                for (int r = 1; r < 16; ++r) pmax = fmaxf(pmax, s0[r]);
#pragma unroll
                for (int r = 0; r < 16; ++r) pmax = fmaxf(pmax, s1[r]);
                pmax = fmaxf(pmax, __shfl_xor(pmax, 32));
                const float mn = fmaxf(mrun, pmax);
                if (__any(mn > mrun)) {
                    const float alpha = __builtin_amdgcn_exp2f(mrun - mn); mrun = mn; lrun *= alpha;
#pragma unroll
                    for (int c = 0; c < 4; ++c)
#pragma unroll
                        for (int r = 0; r < 16; ++r) o[c][r] *= alpha;
                }
                float rs = 0.f;
#pragma unroll
                for (int r = 0; r < 16; ++r) { s0[r] = __builtin_amdgcn_exp2f(s0[r] - mrun); s1[r] = __builtin_amdgcn_exp2f(s1[r] - mrun); rs += s0[r] + s1[r]; }
                lrun += rs;
            }
            bf16x8 pf[2][2];
#pragma unroll
            for (int st = 0; st < 2; ++st) {
                v4u w0, w1;
                w0.x = pg8::cvt_pk_bf16(s0[8 * st + 0], s0[8 * st + 1]); w0.y = pg8::cvt_pk_bf16(s0[8 * st + 2], s0[8 * st + 3]); w0.z = pg8::cvt_pk_bf16(s0[8 * st + 4], s0[8 * st + 5]); w0.w = pg8::cvt_pk_bf16(s0[8 * st + 6], s0[8 * st + 7]);
                w1.x = pg8::cvt_pk_bf16(s1[8 * st + 0], s1[8 * st + 1]); w1.y = pg8::cvt_pk_bf16(s1[8 * st + 2], s1[8 * st + 3]); w1.z = pg8::cvt_pk_bf16(s1[8 * st + 4], s1[8 * st + 5]); w1.w = pg8::cvt_pk_bf16(s1[8 * st + 6], s1[8 * st + 7]);
                pf[0][st] = __builtin_bit_cast(bf16x8, w0); pf[1][st] = __builtin_bit_cast(bf16x8, w1);
            }
#pragma unroll
            for (int c = 2; c < 4; ++c)
#pragma unroll
                for (int blk = 0; blk < 2; ++blk)
#pragma unroll
                    for (int st = 0; st < 2; ++st)
#pragma unroll
                        for (int t = 0; t < 2; ++t) vv[c][blk][st][t] = vtr(Vt + vbase[t] + 2048u * (unsigned)(4 * blk + 2 * st + t) + 512u * (unsigned)c);
            __builtin_amdgcn_sched_barrier(0);
#pragma unroll
            for (int c = 0; c < 4; ++c)
#pragma unroll
                for (int blk = 0; blk < 2; ++blk)
#pragma unroll
                    for (int st = 0; st < 2; ++st) {
                        const s16x4 v0 = vv[c][blk][st][0], v1 = vv[c][blk][st][1];
                        bf16x8 vf; vf[0] = v0[0]; vf[1] = v0[1]; vf[2] = v0[2]; vf[3] = v0[3]; vf[4] = v1[0]; vf[5] = v1[1]; vf[6] = v1[2]; vf[7] = v1[3];
                        o[c] = __builtin_amdgcn_mfma_f32_32x32x16_bf16(vf, pf[blk][st], o[c], 0, 0, 0);
                    }
        }
        asm volatile("s_waitcnt vmcnt(0)" ::: "memory");
        __syncthreads();
    }
#undef AT_STAGE
    bf16* Yg = (bf16*)(ws + WS_BRA + (MODE ? 2 : 1) * SZ_ACT) + (rowbase + tq) * WIDE + h * HD;
    if (MODE == 0) {
        const float lt = lrun + __shfl_xor(lrun, 32), inv = 1.0f / lt;
#pragma unroll
        for (int c = 0; c < 4; ++c)
#pragma unroll
            for (int g = 0; g < 4; ++g) { v2u w; w.x = pg8::cvt_pk_bf16(o[c][4 * g] * inv, o[c][4 * g + 1] * inv); w.y = pg8::cvt_pk_bf16(o[c][4 * g + 2] * inv, o[c][4 * g + 3] * inv);
                *(GAS v2u*)(Yg + 32 * c + 8 * g + 4 * hi) = w; }
    } else {
        float sm = 0.f;
#pragma unroll
        for (int c = 0; c < 4; ++c)
#pragma unroll
            for (int r = 0; r < 16; ++r) sm += o[c][r];
        sm += __shfl_xor(sm, 32);
        const float mu = sm * (1.0f / 128.0f); float vs = 0.f;
#pragma unroll
        for (int c = 0; c < 4; ++c)
#pragma unroll
            for (int r = 0; r < 16; ++r) { const float d = o[c][r] - mu; vs += d * d; }
        vs += __shfl_xor(vs, 32);
        const float rstd = 1.0f / sqrtf(vs * (1.0f / 128.0f) + 1e-5f);
        const bf16* Gg = (const bf16*)(ws + WS_RG) + (rowbase + tq) * WIDE + h * HD;
#pragma unroll
        for (int c = 0; c < 4; ++c)
#pragma unroll
            for (int g = 0; g < 4; ++g) { const v2u gw = *(const GAS v2u*)(Gg + 32 * c + 8 * g + 4 * hi);
                const float g0 = __uint_as_float(gw.x << 16), g1 = __uint_as_float(gw.x & 0xffff0000u), g2 = __uint_as_float(gw.y << 16), g3 = __uint_as_float(gw.y & 0xffff0000u);
                v2u w; w.x = pg8::cvt_pk_bf16((o[c][4 * g] - mu) * rstd * g0, (o[c][4 * g + 1] - mu) * rstd * g1); w.y = pg8::cvt_pk_bf16((o[c][4 * g + 2] - mu) * rstd * g2, (o[c][4 * g + 3] - mu) * rstd * g3);
                *(GAS v2u*)(Yg + 32 * c + 8 * g + 4 * hi) = w; }
    }
}

__device__ __forceinline__ void mix_unit(unsigned char* ws, const float* fbias_l, LAS unsigned char* lds, int b, int h, int qb, int wave, int lane, int tid) {
    mix_nlb(ws, fbias_l, lds, b, h, wave, lane, tid);
    if (wave < 4) mix_half<0>(ws, lds, b, h, qb, wave, lane); else mix_half<1>(ws, lds, b, h, qb, wave - 4, lane);
}

__device__ __forceinline__ void unpack8(const v4u x, float (&f)[8]) {
    f[0] = __uint_as_float(x.x << 16); f[1] = __uint_as_float(x.x & 0xffff0000u); f[2] = __uint_as_float(x.y << 16); f[3] = __uint_as_float(x.y & 0xffff0000u);
    f[4] = __uint_as_float(x.z << 16); f[5] = __uint_as_float(x.z & 0xffff0000u); f[6] = __uint_as_float(x.w << 16); f[7] = __uint_as_float(x.w & 0xffff0000u); }
template <int W>
__device__ __forceinline__ void pool_rows(const bf16* U, bf16* P, int r0, int c0) {
    const int t0 = r0 & (SEQ - 1);
    v4u x[7 + W];
#pragma unroll
    for (int i = 0; i < 7 + W; ++i) { const int dr = i - (W - 1); x[i] = (t0 + dr >= 0) ? *(const GAS v4u*)(U + (size_t)(r0 + dr) * WIDE + c0) : (v4u){0u, 0u, 0u, 0u}; }
    float s[8];
#pragma unroll
    for (int e = 0; e < 8; ++e) s[e] = 0.f;
#pragma unroll
    for (int i = 0; i < W - 1; ++i) { float f[8]; unpack8(x[i], f);
#pragma unroll
        for (int e = 0; e < 8; ++e) s[e] += f[e]; }
#pragma unroll
    for (int i = 0; i < 8; ++i) {
        float cur[8]; unpack8(x[W - 1 + i], cur);
#pragma unroll
        for (int e = 0; e < 8; ++e) s[e] += cur[e];
        const int t = t0 + i; const float ic = 1.0f / (float)((t + 1 < W) ? t + 1 : W);
        v4u o; o.x = pk2(s[0] * ic - cur[0], s[1] * ic - cur[1]); o.y = pk2(s[2] * ic - cur[2], s[3] * ic - cur[3]); o.z = pk2(s[4] * ic - cur[4], s[5] * ic - cur[5]); o.w = pk2(s[6] * ic - cur[6], s[7] * ic - cur[7]);
        *(GAS v4u*)(P + (size_t)(r0 + i) * WIDE + c0) = o;
        float old[8]; unpack8(x[i], old);
#pragma unroll
        for (int e = 0; e < 8; ++e) s[e] -= old[e];
    }
}
__device__ __forceinline__ void pool_item(unsigned char* ws, int item, int wave, int lane) {
    const bf16* U = (const bf16*)(ws + WS_U); bf16* P = (bf16*)(ws + WS_BRA);
    const int g = wave & 3, c0 = g * 256 + (lane & 31) * 8, r0 = item * 64 + ((wave >> 2) * 2 + (lane >> 5)) * 16;
#pragma unroll 1
    for (int hp = 0; hp < 2; ++hp) { const int r = r0 + 8 * hp;
        if (g == 0) pool_rows<2>(U, P, r, c0); else if (g == 1) pool_rows<4>(U, P, r, c0); else if (g == 2) pool_rows<8>(U, P, r, c0); else pool_rows<16>(U, P, r, c0); }
}

__global__ void __launch_bounds__(NWAVES * 64, 2) mk_fwd(Args args) {
    extern __shared__ __attribute__((aligned(16))) unsigned char lds_raw[];
    LAS unsigned char* lds = (LAS unsigned char*)lds_raw;
    volatile LAS unsigned* MISC = (volatile LAS unsigned*)(lds + MISC_OFF);
    const int tid0 = threadIdx.x;
#define OPAQUE_TID() int tid = tid0; asm volatile("" : "+v"(tid)); const int lane = tid & 63, wave = __builtin_amdgcn_readfirstlane(tid >> 6); (void)lane; (void)wave
    const int G = gridDim.x;
    unsigned char* ws = args.ws;
    gu32* ctl = (gu32*)(ws + WS_CTL);
    for (int u = tid0; u < (LDS_BYTES - LDSCTL_OFF) / 4; u += NWAVES * 64) ((LAS unsigned*)(lds + LDSCTL_OFF))[u] = 0u;
    __syncthreads();
#if MK_PER_PHASE
    XcdBarrier bar; bar.bar = (unsigned*)(ctl + CW_BAR); bar.x = 0; bar.st = nullptr;
#define GRID_BAR() do { if (tid0 == 0) __hip_atomic_store(ctl + CW_TMO, 0xBADBA0u, RLX_AGENT); } while (0)
#else
    XcdBarrier bar = xcd_barrier_post((unsigned*)(ctl + CW_BAR), MISC + 8);
#define GRID_BAR() xcd_barrier(bar)
#endif
    const int lo = args.ph_lo, hi = args.ph_hi;
    int p = 0;
#define IN(k) (lo <= (k) && (k) < hi)
#ifndef MK_OFF
#define MK_OFF 0
#endif
#define PH_ON(n) (!((MK_OFF) & (1 << (n))))
#ifndef MK_DUP
#define MK_DUP 0
#endif
#define NREP(n) ((((MK_DUP) >> (n)) & 1) ? 2 : 1)
#ifndef MK_BAR2
#define MK_BAR2 0
#endif
#define SEAM() do { if (IN(p) && IN(p + 1)) { GRID_BAR(); if (MK_BAR2) GRID_BAR(); } ++p; } while (0)

    bf16* XB = (bf16*)(ws + WS_XB); float* X = (float*)(ws + WS_X); float* SS = (float*)(ws + WS_SS);

    if (PH_ON(0) && IN(p)) for (int rep = 0; rep < NREP(0); ++rep) { OPAQUE_TID(); p0_prologue(args, lds, wave, lane, tid, G); if (rep + 1 < NREP(0)) GRID_BAR(); }
    SEAM();

    if (PH_ON(8) && IN(p)) {
        pg8::Gemm g{(const bf16*)(ws + WS_WBPT), (const bf16*)(ws + WS_WP), 16 * D, 16 * 256, 256}; pg8::FoldOrder S{(int)blockIdx.x};
        pg8::EpiFold E{(bf16*)(ws + WS_WBR), SZ_WBR / 2};
        for (int rep = 0; rep < NREP(8); ++rep) { pg8::gemm_phase<pg8::EpiFold, pg8::FoldOrder, false, true>(lds + RING_OFF, g, S, E); if (rep + 1 < NREP(8)) GRID_BAR(); }
    }
    SEAM();

    for (int j = 0; j < 2 * DEPTH; ++j) {
        const int l = j >> 1;
        if (PH_ON(1) && IN(p)) {
            pg8::Gemm g{XB, (const bf16*)(ws + WS_W13T + (size_t)j * SZ_W13T), M, 2 * DFF, D}; pg8::StaticOrder S; S.init(M, 2 * DFF, G, (int)blockIdx.x);
            pg8::EpiSwiGLU E{(bf16*)(ws + WS_H), SS, DFF};
            for (int rep = 0; rep < NREP(1); ++rep) { pg8::gemm_phase<pg8::EpiSwiGLU, pg8::StaticOrder, true, true>(lds + RING_OFF, g, S, E); if (rep + 1 < NREP(1)) GRID_BAR(); }
        }
        SEAM();
        if (PH_ON(2) && IN(p)) {
            pg8::Gemm g{(const bf16*)(ws + WS_H), (const bf16*)(ws + WS_W2T + (size_t)j * SZ_W2T), M, D, DFF}; pg8::StaticOrder S; S.init(M, D, G, (int)blockIdx.x);
            for (int rep = 0; rep < NREP(2); ++rep) { pg8::EpiResid E{j == 0 ? args.in[I_X] : (const float*)X, X, XB, SS, rep + 1 < NREP(2) ? 0.0f : 0.5f};
                pg8::gemm_phase<pg8::EpiResid, pg8::StaticOrder, false, true>(lds + RING_OFF, g, S, E); if (rep + 1 < NREP(2)) GRID_BAR(); }
        }
        SEAM();
        if (j & 1) continue;
        if (PH_ON(3) && IN(p)) {
            for (int rep = 0; rep < NREP(9); ++rep) { OPAQUE_TID(); flogit_rows(ws, l, wave, lane); }
            pg8::Gemm g{XB, (const bf16*)(ws + WS_WINT + (size_t)l * SZ_WINT), M, WIN_N, D}; pg8::StaticOrder S; S.init(M, WIN_N, G, (int)blockIdx.x);
            pg8::EpiWin E{SS, (bf16*)(ws + WS_U), (bf16*)(ws + WS_FQ), (bf16*)(ws + WS_FK), (bf16*)(ws + WS_FV), (bf16*)(ws + WS_RQ), (bf16*)(ws + WS_RK), (bf16*)(ws + WS_RV), (bf16*)(ws + WS_RG), (bf16*)(ws + WS_GATES),
                          (const float*)(ws + WS_COS), (const float*)(ws + WS_SIN)};
            for (int rep = 0; rep < NREP(3); ++rep) { pg8::gemm_phase<pg8::EpiWin, pg8::StaticOrder, true, true>(lds + RING_OFF, g, S, E); if (rep + 1 < NREP(3)) GRID_BAR(); }
        }
        SEAM();
        if (PH_ON(4) && IN(p)) {
            OPAQUE_TID();
            const float* fb = args.in[I_FB] + l * NH;
            for (int rep = 0; rep < NREP(4); ++rep) {
            gu32* head = ctl + CW_QUEUE + 64 * l + 512 * rep;
            for (;;) {
                __syncthreads();
                if (tid == 0) MISC[0] = __hip_atomic_fetch_add(head, 1u, RLX_AGENT);
                __syncthreads();
                const int it = (int)MISC[0];
                if (it >= 512 + 128) break;
                if (it < 512) { const int qb = 15 - (it >> 5), bh = it & 31; mix_unit(ws, fb, lds, bh >> 3, bh & 7, qb, wave, lane, tid); }
                else pool_item(ws, it - 512, wave, lane);
            }
            if (rep + 1 < NREP(4)) GRID_BAR(); }
        }
        SEAM();
        if (PH_ON(5) && IN(p)) {
            pg8::Gemm g{(const bf16*)(ws + WS_BRA), (const bf16*)(ws + WS_WBR + (size_t)l * SZ_WBR), 3 * M, 3 * D, WIDE}; pg8::BranchOrder S; S.so.init(M, D, G, (int)blockIdx.x);
            pg8::EpiBranch E{(const bf16*)(ws + WS_GATES), (bf16*)(ws + WS_MGB)};
            for (int rep = 0; rep < NREP(5); ++rep) { pg8::gemm_phase<pg8::EpiBranch, pg8::BranchOrder, true, true>(lds + RING_OFF, g, S, E); if (rep + 1 < NREP(5)) GRID_BAR(); }
        }
        SEAM();
        if (PH_ON(6) && IN(p)) {
            pg8::Gemm g{(const bf16*)(ws + WS_MGB), (const bf16*)(ws + WS_WOUT + (size_t)l * SZ_WOUT), M, D, D}; pg8::StaticOrder S; S.init(M, D, G, (int)blockIdx.x);
            for (int rep = 0; rep < NREP(6); ++rep) { pg8::EpiResid E{(const float*)X, X, XB, SS, rep + 1 < NREP(6) ? 0.0f : 1.0f};
                pg8::gemm_phase<pg8::EpiResid, pg8::StaticOrder, false, true>(lds + RING_OFF, g, S, E); if (rep + 1 < NREP(6)) GRID_BAR(); }
        }
        SEAM();
    }
    if (PH_ON(7) && IN(p)) {
        OPAQUE_TID();
        const unsigned bad = __hip_atomic_load(ctl + CW_TMO, RLX_AGENT) | __hip_atomic_load(ctl + CW_BAR + XB_TMO, RLX_AGENT);
        const float* gf = args.in[I_FINN];
        for (int rep = 0; rep < NREP(7); ++rep)
        for (int m = (int)blockIdx.x * NWAVES + wave; m < M; m += G * NWAVES) {
            const float rs = bad ? __builtin_nanf("") : pg8::row_rstd(SS, m);
            const GAS f32x4* xr = (const GAS f32x4*)(X + (size_t)m * D) + lane; GAS f32x4* orow = (GAS f32x4*)(args.out + (size_t)m * D) + lane;
#pragma unroll
            for (int k = 0; k < 8; ++k) { const f32x4 v = xr[64 * k], gv = *((const GAS f32x4*)gf + lane + 64 * k); orow[64 * k] = v * rs * gv; }
        }
    }
#undef IN
#undef SEAM
#undef GRID_BAR
}

extern "C" void kernel_launch(void* const* d_in, const int* in_sizes, int n_in, void* d_out, int out_size, void* d_ws, size_t ws_size, hipStream_t stream) {
    static int grid = 0;
    if (grid == 0) {
        if (n_in != 17 || in_sizes[0] != M * D || out_size != M * D || ws_size < WS_END) { fprintf(stderr, "kernel_launch: unexpected shapes (n_in %d, in0 %d, out %d, ws %zu < %zu); nothing launched\n", n_in, n_in > 0 ? in_sizes[0] : -1, out_size, ws_size, (size_t)WS_END); grid = -1; return; }
        int dev = 0, cus = 0, per_cu = 0;
        if (hipGetDevice(&dev) != hipSuccess || hipDeviceGetAttribute(&cus, hipDeviceAttributeMultiprocessorCount, dev) != hipSuccess) { grid = -1; return; }
        if (hipFuncSetAttribute((const void*)mk_fwd, hipFuncAttributeMaxDynamicSharedMemorySize, LDS_BYTES) != hipSuccess) { fprintf(stderr, "kernel_launch: hipFuncSetAttribute failed\n"); grid = -1; return; }
        if (hipOccupancyMaxActiveBlocksPerMultiprocessor(&per_cu, (const void*)mk_fwd, NWAVES * 64, LDS_BYTES) != hipSuccess || per_cu < 1) { fprintf(stderr, "kernel_launch: occupancy query says %d workgroups per CU\n", per_cu); }
        (void)hipGetLastError();
        if (cus != 256) { fprintf(stderr, "kernel_launch: built for 256 CUs, device has %d; nothing launched\n", cus); grid = -1; return; }
        grid = 256;
    }
    if (grid < 0) return;
    if (hipMemsetAsync((char*)d_ws + WS_CTL, 0, CTL_ZERO_BYTES, stream) != hipSuccess) return;
    Args a{};
    for (int i = 0; i < 17; ++i) a.in[i] = (const float*)d_in[i];
    a.out = (float*)d_out; a.ws = (unsigned char*)d_ws;
#if MK_PER_PHASE
    for (int li = 0; li < N_PHASES; ++li) { a.ph_lo = li; a.ph_hi = li + 1; a.li = li; hipLaunchKernelGGL(mk_fwd, dim3(grid), dim3(NWAVES * 64), LDS_BYTES, stream, a); }
#else
    a.ph_lo = 0; a.ph_hi = N_PHASES; a.li = 0;
    hipLaunchKernelGGL(mk_fwd, dim3(grid), dim3(NWAVES * 64), LDS_BYTES, stream, a);
#endif
    const hipError_t le = hipPeekAtLastError();
    if (le != hipSuccess) fprintf(stderr, "kernel_launch: launch failed: %s\n", hipGetErrorName(le));
}
```

```cpp
#include <hip/hip_runtime.h>
#include <cstdio>
#include <cstdint>
#include <cmath>
namespace pg8 {
#define PG8_LAS __attribute__((address_space(3)))
typedef unsigned short bf16_t;
typedef short bf16x8 __attribute__((ext_vector_type(8)));
typedef float f32x4 __attribute__((ext_vector_type(4)));
typedef unsigned u32x4 __attribute__((ext_vector_type(4)));
constexpr int BM = 256, BK = 64, HALF = 128, HTB = HALF * BK * 2  , STAGE_BYTES = 8 * HTB, NXCD = 8, WGM = 8;

__host__ __device__ __forceinline__ int lds_byte(int r, int c) { const int st = (r >> 4) * 2 + (c >> 5), rr = r & 15, cc = c & 31, ob = rr * 64 + cc * 2; return st * 1024 + (ob ^ (((ob >> 9) & 1) << 5)); }
__host__ __device__ __forceinline__ void stage_rc(int b, int& R, int& C) { const int st = b / 1024, sb = b % 1024, swz = sb ^ (((sb >> 9) & 1) << 5); R = (st >> 1) * 16 + swz / 64; C = (st & 1) * 32 + (swz % 64) / 2; }
__host__ __device__ __forceinline__ int perm32(int rho) { const int n = rho >> 4, i = rho & 15; return 8 * (i >> 2) + 4 * n + (i & 3); }

struct Unit { int pm, pn; };
struct Gemm { const bf16_t* A; const bf16_t* Bt; int M, N, K; };

struct StaticOrder {
    int nM, nN, nwg, G, c;
    __host__ __device__ void init(int M, int N, int G_, int c_) { nM = M / BM; nN = N / BM; nwg = nM * nN; G = G_; c = c_; }
    __host__ __device__ bool next(int i, Unit& u) const {
        const long L = (long)i * G + c; if (L >= nwg) return false;
        int wgid = (int)L; { const int q = nwg / NXCD, r = nwg % NXCD, xcd = wgid % NXCD, off = wgid / NXCD; wgid = (xcd < r ? xcd * (q + 1) : r * (q + 1) + (xcd - r) * q) + off; }
        const int nig = WGM * nN, gid = wgid / nig, fm = gid * WGM, gsz = (nM - fm) < WGM ? (nM - fm) : WGM;
        u.pm = fm + ((wgid % nig) % gsz); u.pn = (wgid % nig) / gsz; return true;
    }
    __device__ __forceinline__ void a_ready(const Unit&) const {}
    __device__ __forceinline__ void done(const Unit&) const {}
};

__device__ __forceinline__ unsigned cvt_pk_bf16(float lo, float hi) { unsigned r; asm volatile("v_cvt_pk_bf16_f32 %0, %1, %2" : "=v"(r) : "v"(lo), "v"(hi)); return r; }
typedef float f32x2 __attribute__((ext_vector_type(2)));
typedef unsigned u32x2v __attribute__((ext_vector_type(2)));
constexpr int DM = 2048;
constexpr float LOG2E = 1.4426950408889634f;
__device__ __forceinline__ float fast_sigmoid(float x) { return __builtin_amdgcn_rcpf(1.0f + __builtin_amdgcn_exp2f(-x * LOG2E)); }
__device__ __forceinline__ float fast_silu(float x) { return x * fast_sigmoid(x); }
__device__ __forceinline__ float gate_sig(float x) { return fmaxf(fast_sigmoid(x), 1e-18f); }
__device__ __forceinline__ u32x4 pack8(const f32x4 a, const f32x4 b) { u32x4 w; w.x = cvt_pk_bf16(a[0], a[1]); w.y = cvt_pk_bf16(a[2], a[3]); w.z = cvt_pk_bf16(b[0], b[1]); w.w = cvt_pk_bf16(b[2], b[3]); return w; }
__device__ __forceinline__ f32x4 bf_lo4(const u32x4 w) { return (f32x4){__uint_as_float(w.x << 16), __uint_as_float(w.x & 0xffff0000u), __uint_as_float(w.y << 16), __uint_as_float(w.y & 0xffff0000u)}; }
__device__ __forceinline__ f32x4 bf_hi4(const u32x4 w) { return (f32x4){__uint_as_float(w.z << 16), __uint_as_float(w.z & 0xffff0000u), __uint_as_float(w.w << 16), __uint_as_float(w.w & 0xffff0000u)}; }
__device__ __forceinline__ float row_rstd(const float* ss, int row) {
    const f32x4 a = *(const f32x4*)(ss + (size_t)row * 8), b = *(const f32x4*)(ss + (size_t)row * 8 + 4);
    const float s = ((a[0] + a[1]) + (a[2] + a[3])) + ((b[0] + b[1]) + (b[2] + b[3]));
    return 1.0f / sqrtf(s * (1.0f / (float)DM) + 1e-6f);
}

__device__ __forceinline__ void wave_rstd(const float* ss, int rowbase, int lane, int fr, float (&rs)[2][4]) {
    const float r0 = row_rstd(ss, rowbase + lane), r1 = row_rstd(ss, rowbase + HALF + lane);
#pragma unroll
    for (int m = 0; m < 4; ++m) { rs[0][m] = __shfl(r0, m * 16 + fr); rs[1][m] = __shfl(r1, m * 16 + fr); }
}

struct EpiSwiGLU {
    static constexpr bool PERM = true, AFTER_DRAIN = false, KEEP_ACC = false;
    bf16_t* H; const float* ss; int ldh;
    __device__ __forceinline__ void operator()(const f32x4 (&acc)[2][2][4][2], const Unit& u, int wr, int wc, int fr, int fq) const {
        const int row0 = u.pm * BM + wr * 64 + fr, col0 = u.pn * HALF + wc * 32 + 8 * fq;
        float rsv[2][4]; wave_rstd(ss, u.pm * BM + wr * 64, fq * 16 + fr, fr, rsv);
#pragma unroll
        for (int ai = 0; ai < 2; ++ai)
#pragma unroll
            for (int m = 0; m < 4; ++m) {
                const int row = row0 + ai * HALF + m * 16; const float rs = rsv[ai][m];
                f32x4 h[2];
#pragma unroll
                for (int n = 0; n < 2; ++n) { const f32x4 a = acc[ai][0][m][n] * rs, b = acc[ai][1][m][n] * rs;
                    h[n] = (f32x4){fast_silu(a[0]) * b[0], fast_silu(a[1]) * b[1], fast_silu(a[2]) * b[2], fast_silu(a[3]) * b[3]}; }
                *(u32x4*)(H + (size_t)row * ldh + col0) = pack8(h[0], h[1]);
                asm volatile("" ::: "memory");
            }
    }
};

struct EpiResid {
    static constexpr bool PERM = true, AFTER_DRAIN = true, KEEP_ACC = false;
    const float* xin; float* xout; bf16_t* xb; float* ss; float coef;
    __device__ __forceinline__ void fused(f32x4 (&acc)[2][2][4][2], const Unit& u, int wr, int wc, int fr, int fq, PG8_LAS unsigned char* lds, int wid, int lane) const {
        PG8_LAS float* P = (PG8_LAS float*)lds;
        const int row0 = u.pm * BM + wr * 64 + fr, col0 = u.pn * BM + wc * 32 + 8 * fq;
#pragma unroll
        for (int ai = 0; ai < 2; ++ai) {
            f32x4 xv[4][2][2];
#pragma unroll
            for (int m = 0; m < 4; ++m)
#pragma unroll
                for (int bj = 0; bj < 2; ++bj) { const size_t off = (size_t)(row0 + ai * HALF + m * 16) * DM + col0 + bj * HALF; xv[m][bj][0] = *(const f32x4*)(xin + off); xv[m][bj][1] = *(const f32x4*)(xin + off + 4); }
            asm volatile("" ::: "memory");
#pragma unroll
            for (int m = 0; m < 4; ++m) {
                const int row = row0 + ai * HALF + m * 16; float sq = 0.f;
#pragma unroll
                for (int bj = 0; bj < 2; ++bj) { const size_t off = (size_t)row * DM + col0 + bj * HALF;
                    f32x4 v0 = xv[m][bj][0], v1 = xv[m][bj][1];
                    v0 = v0 + acc[ai][bj][m][0] * coef; v1 = v1 + acc[ai][bj][m][1] * coef;
                    *(f32x4*)(xout + off) = v0; *(f32x4*)(xout + off + 4) = v1; *(u32x4*)(xb + off) = pack8(v0, v1);
                    sq += ((v0[0] * v0[0] + v0[1] * v0[1]) + (v0[2] * v0[2] + v0[3] * v0[3])) + ((v1[0] * v1[0] + v1[1] * v1[1]) + (v1[2] * v1[2] + v1[3] * v1[3])); }
                sq += __shfl_xor(sq, 16); sq += __shfl_xor(sq, 32);
                if (fq == 0) P[(ai * HALF + wr * 64 + m * 16 + fr) * 4 + wc] = sq;
            }
            asm volatile("" ::: "memory");
        }
        asm volatile("s_waitcnt lgkmcnt(0)" ::: "memory"); __builtin_amdgcn_s_barrier(); asm volatile("" ::: "memory");
        const int t = wid * 64 + lane;
        if (t < 256) { const f32x4 p = *(const PG8_LAS f32x4*)(P + t * 4); ss[(size_t)(u.pm * BM + t) * 8 + u.pn] = (p[0] + p[1]) + (p[2] + p[3]); }
        asm volatile("s_waitcnt lgkmcnt(0)" ::: "memory"); __builtin_amdgcn_s_barrier(); asm volatile("" ::: "memory");
    }
};

struct EpiWin {
    static constexpr bool PERM = true, AFTER_DRAIN = false, KEEP_ACC = false;
    const float* ss; bf16_t *U, *FQ, *FK, *FV, *RQ, *RK, *RV, *RG, *GATES; const float *rcos, *rsin;
    __device__ __forceinline__ void operator()(const f32x4 (&acc)[2][2][4][2], const Unit& u, int wr, int wc, int fr, int fq) const {
        const int row0 = u.pm * BM + wr * 64 + fr; const int reg = u.pn >> 2;
        if (reg == 4 || reg == 5) {
            const int head = 2 * (u.pn & 3) + (wc >> 1), j0 = 32 * (wc & 1) + 8 * fq;
            const float lg = log2f(1.0f - exp2f(-5.0f - (float)head));
            bf16_t* dst = (reg == 4) ? RQ : RK;
            float rsv[2][4]; wave_rstd(ss, u.pm * BM + wr * 64, fq * 16 + fr, fr, rsv);
#pragma unroll
            for (int ai = 0; ai < 2; ++ai)
#pragma unroll
                for (int mp = 0; mp < 2; ++mp) {
                    f32x4 cs[2][2], sn[2][2];
#pragma unroll
                    for (int mm = 0; mm < 2; ++mm) { const int t = (row0 + ai * HALF + (2 * mp + mm) * 16) & 2047;
#pragma unroll
                        for (int n = 0; n < 2; ++n) { cs[mm][n] = *(const f32x4*)(rcos + t * 64 + j0 + 4 * n); sn[mm][n] = *(const f32x4*)(rsin + t * 64 + j0 + 4 * n); } }
                    asm volatile("" ::: "memory");
#pragma unroll
                    for (int mm = 0; mm < 2; ++mm) { const int m = 2 * mp + mm, row = row0 + ai * HALF + m * 16, t = row & 2047;
                        const float sc = rsv[ai][m] * ((reg == 4) ? exp2f((float)t * lg) * 0.08838834764831845f : exp2f(-(float)t * lg));
                        f32x4 o1[2], o2[2];
#pragma unroll
                        for (int n = 0; n < 2; ++n) { const f32x4 x1 = acc[ai][0][m][n] * sc, x2 = acc[ai][1][m][n] * sc; o1[n] = x1 * cs[mm][n] - x2 * sn[mm][n]; o2[n] = x1 * sn[mm][n] + x2 * cs[mm][n]; }
                        bf16_t* p = dst + (size_t)row * 1024 + head * 128 + j0;
                        *(u32x4*)p = pack8(o1[0], o1[1]); *(u32x4*)(p + 64) = pack8(o2[0], o2[1]); }
                    asm volatile("" ::: "memory");
                }
            return;
        }
        bf16_t* dst; int ldc, colt; int act = 0; float mul = 1.f;
        if (reg < 8) { ldc = 1024; colt = (u.pn & 3) * BM;
            dst = reg == 0 ? U : reg == 1 ? FQ : reg == 2 ? FK : reg == 3 ? FV : reg == 6 ? RV : RG;
            if (reg == 1) mul = 0.08838834764831845f * LOG2E;
            if (reg == 7) act = 1; }
        else { ldc = 6144; colt = (u.pn - 32) * BM; dst = GATES; act = 2; }
        const int col0 = colt + wc * 32 + 8 * fq;
        float rsv[2][4]; wave_rstd(ss, u.pm * BM + wr * 64, fq * 16 + fr, fr, rsv);
#pragma unroll
        for (int ai = 0; ai < 2; ++ai)
#pragma unroll
            for (int m = 0; m < 4; ++m) {
                const int row = row0 + ai * HALF + m * 16; const float rs = rsv[ai][m] * mul;
#pragma unroll
                for (int bj = 0; bj < 2; ++bj) { f32x4 v0 = acc[ai][bj][m][0] * rs, v1 = acc[ai][bj][m][1] * rs;
                    if (act == 1) { v0 = (f32x4){fast_silu(v0[0]), fast_silu(v0[1]), fast_silu(v0[2]), fast_silu(v0[3])}; v1 = (f32x4){fast_silu(v1[0]), fast_silu(v1[1]), fast_silu(v1[2]), fast_silu(v1[3])}; }
                    if (act == 2) { v0 = (f32x4){gate_sig(v0[0]), gate_sig(v0[1]), gate_sig(v0[2]), gate_sig(v0[3])}; v1 = (f32x4){gate_sig(v1[0]), gate_sig(v1[1]), gate_sig(v1[2]), gate_sig(v1[3])}; }
                    *(u32x4*)(dst + (size_t)row * ldc + col0 + bj * HALF) = pack8(v0, v1); }
                asm volatile("" ::: "memory");
            }
    }
};

struct EpiBranch {
    static constexpr bool PERM = true, AFTER_DRAIN = false, KEEP_ACC = true;
    const bf16_t* GATES; bf16_t* MGB;
    __device__ __forceinline__ void operator()(f32x4 (&acc)[2][2][4][2], const Unit& u, int wr, int wc, int fr, int fq) const {
        const int br = u.pm >> 5, pm = u.pm & 31, pn = u.pn & 7;
        const int row0 = pm * BM + wr * 64 + fr, col0 = pn * BM + wc * 32 + 8 * fq;
#pragma unroll
        for (int ai = 0; ai < 2; ++ai) {
            u32x4 gc[4][2], gx[4][2];
#pragma unroll
            for (int m = 0; m < 4; ++m)
#pragma unroll
                for (int bj = 0; bj < 2; ++bj) { const bf16_t* gp = GATES + (size_t)(row0 + ai * HALF + m * 16) * 6144 + br * DM + col0 + bj * HALF;
                    gc[m][bj] = *(const u32x4*)gp; gx[m][bj] = (br < 2) ? *(const u32x4*)(gp + DM) : gc[m][bj]; }
            asm volatile("" ::: "memory");
#pragma unroll
            for (int m = 0; m < 4; ++m) {
                const int row = row0 + ai * HALF + m * 16;
#pragma unroll
                for (int bj = 0; bj < 2; ++bj) {
                    const u32x4 g = gc[m][bj]; f32x4 s0 = bf_lo4(g), s1 = bf_hi4(g);
                    if (br < 2) { const u32x4 gn = gx[m][bj]; s0 = s0 / bf_lo4(gn); s1 = s1 / bf_hi4(gn);
                        acc[ai][bj][m][0] = acc[ai][bj][m][0] * s0; acc[ai][bj][m][1] = acc[ai][bj][m][1] * s1; }
                    else { *(u32x4*)(MGB + (size_t)row * DM + col0 + bj * HALF) = pack8(acc[ai][bj][m][0] * s0, acc[ai][bj][m][1] * s1);
                        acc[ai][bj][m][0] = (f32x4){0.f, 0.f, 0.f, 0.f}; acc[ai][bj][m][1] = (f32x4){0.f, 0.f, 0.f, 0.f}; } }
            }
            asm volatile("" ::: "memory");
        }
    }
};
struct BranchOrder {
    StaticOrder so;
    __device__ bool next(int i, Unit& u) const { if (i >= 3) return false; Unit t; if (!so.next(0, t)) return false; u.pm = i * 32 + t.pm; u.pn = i * 8 + t.pn; return true; }
    __device__ __forceinline__ void a_ready(const Unit&) const {}
    __device__ __forceinline__ void done(const Unit&) const {}
};

struct EpiFold {
    static constexpr bool PERM = true, AFTER_DRAIN = false, KEEP_ACC = false;
    bf16_t* WBR; size_t layer_stride;
    __device__ __forceinline__ void operator()(const f32x4 (&acc)[2][2][4][2], const Unit& u, int wr, int wc, int fr, int fq) const {
        const int lg = u.pn, l = lg >> 2, g = lg & 3, ob = (u.pm & 7) * BM;
        bf16_t* base = WBR + (size_t)l * layer_stride + g * 256 + wc * 32 + 8 * fq;
#pragma unroll
        for (int ai = 0; ai < 2; ++ai)
#pragma unroll
            for (int m = 0; m < 4; ++m) { const int o = ob + ai * HALF + wr * 64 + m * 16 + fr;
#pragma unroll
                for (int bj = 0; bj < 2; ++bj) *(u32x4*)(base + (size_t)o * 1024 + bj * HALF) = pack8(acc[ai][bj][m][0], acc[ai][bj][m][1]); }
    }
};
struct FoldOrder {
    int c;
    __device__ bool next(int i, Unit& u) const { if (i > 0 || c >= 128) return false; u.pm = c; u.pn = c >> 3; return true; }
    __device__ __forceinline__ void a_ready(const Unit&) const {}
    __device__ __forceinline__ void done(const Unit&) const {}
};

template <class Epi, class Sched, bool ALIGN_EPI = false, bool SP2 = false>
__device__ __forceinline__ void gemm_phase(PG8_LAS unsigned char* lds, const Gemm g, const Sched& S, const Epi& E) {
    int tid_ = threadIdx.x; asm volatile("" : "+v"(tid_));
    const int tid = tid_, wid = __builtin_amdgcn_readfirstlane(tid >> 6), lane = tid & 63, wr = wid >> 2, wc = wid & 3, fr = lane & 15, fq = lane >> 4;
    const int K = g.K, nt = K / BK;
    unsigned voffA[2], voffB[2];
#pragma unroll
    for (int i = 0; i < 2; ++i) { int R, C; stage_rc(tid * 16 + i * 8192, R, C); const int Rb = Epi::PERM ? ((R & ~31) + perm32(R & 31)) : R;
        voffA[i] = (unsigned)(R * K + C) * 2u; voffB[i] = (unsigned)(Rb * K + C) * 2u; }
    const size_t kstep = (size_t)(BK * 2);
    const size_t hstep = (size_t)HALF * K * 2;
    const size_t tstep = 2 * hstep;
    const unsigned ldsw = (unsigned)wid * 1024u;
    const int aoff = lds_byte(wr * 64 + fr, fq * 8), boff = lds_byte(wc * 32 + fr, fq * 8);
#define PG8_SA(b, h) (((b) * 2 + (h)) * HTB)
#define PG8_SB(b, h) ((4 + (b) * 2 + (h)) * HTB)
#define PG8_STAGE(bufoff, gbase, voff) do { _Pragma("unroll") for (int _i = 0; _i < 2; ++_i) \
        __builtin_amdgcn_global_load_lds((const unsigned*)((const char*)(gbase) + (voff)[_i]), (PG8_LAS unsigned*)(lds + (bufoff) + ldsw + _i * 8192), 16, 0, 0); } while (0)
#define PG8_LDA(dst, b, h) do { _Pragma("unroll") for (int m = 0; m < 4; ++m) _Pragma("unroll") for (int k = 0; k < 2; ++k) dst[m][k] = *(const PG8_LAS bf16x8*)(lds + PG8_SA(b, h) + aoff + m * 2048 + k * 1024); } while (0)
#define PG8_LDB(dst, b, h) do { _Pragma("unroll") for (int n = 0; n < 2; ++n) _Pragma("unroll") for (int k = 0; k < 2; ++k) dst[n][k] = *(const PG8_LAS bf16x8*)(lds + PG8_SB(b, h) + boff + n * 2048 + k * 1024); } while (0)
#define PG8_MMA(ai, bj, At, Bt) do { __builtin_amdgcn_s_setprio(1); _Pragma("unroll") for (int m = 0; m < 4; ++m) _Pragma("unroll") for (int n = 0; n < 2; ++n) _Pragma("unroll") for (int k = 0; k < 2; ++k) \
        acc[ai][bj][m][n] = __builtin_amdgcn_mfma_f32_16x16x32_bf16(Bt[n][k], At[m][k], acc[ai][bj][m][n], 0, 0, 0); __builtin_amdgcn_s_setprio(0); } while (0)
#define PG8_WAIT_V(n) asm volatile("s_waitcnt vmcnt(" #n ")" ::: "memory")
#define PG8_WAIT_L(n) asm volatile("s_waitcnt lgkmcnt(" #n ")" ::: "memory")
#define PG8_BAR __builtin_amdgcn_s_barrier()
#define PG8_SCHED __builtin_amdgcn_sched_barrier(0)
    Unit cur, nxt; int ui = 0;
    if (!S.next(0, cur)) return;
    f32x4 acc[2][2][4][2];
#pragma unroll
    for (int a = 0; a < 2; ++a)
#pragma unroll
        for (int b = 0; b < 2; ++b)
#pragma unroll
            for (int m = 0; m < 4; ++m)
#pragma unroll
                for (int n = 0; n < 2; ++n) acc[a][b][m][n] = (f32x4){0.f, 0.f, 0.f, 0.f};
    bf16x8 At[4][2], B0[2][2], B1[2][2];
    const char* cA = (const char*)g.A + (size_t)cur.pm * tstep; const char* cB = (const char*)g.Bt + (size_t)cur.pn * tstep;
    S.a_ready(cur);
    if constexpr (SP2) {
        PG8_STAGE(PG8_SB(0, 0), cB, voffB); PG8_STAGE(PG8_SB(0, 1), cB + hstep, voffB); PG8_STAGE(PG8_SA(0, 0), cA, voffA); PG8_STAGE(PG8_SA(0, 1), cA + hstep, voffA);
        if (wr == 1) PG8_BAR;
        PG8_WAIT_V(2); PG8_BAR;
        PG8_STAGE(PG8_SB(1, 0), cB + kstep, voffB); PG8_STAGE(PG8_SA(1, 0), cA + kstep, voffA); PG8_STAGE(PG8_SB(1, 1), cB + hstep + kstep, voffB);
        PG8_WAIT_V(6); PG8_BAR;
    } else {
        PG8_STAGE(PG8_SB(0, 0), cB, voffB); PG8_STAGE(PG8_SA(0, 0), cA, voffA); PG8_STAGE(PG8_SB(0, 1), cB + hstep, voffB); PG8_STAGE(PG8_SA(0, 1), cA + hstep, voffA);
        if (wr == 1) PG8_BAR;
        PG8_WAIT_V(4); PG8_BAR;
        PG8_STAGE(PG8_SB(1, 0), cB + kstep, voffB); PG8_STAGE(PG8_SA(1, 0), cA + kstep, voffA); PG8_STAGE(PG8_SB(1, 1), cB + hstep + kstep, voffB);
        PG8_WAIT_V(6); PG8_BAR;
    }
    for (;;) {
        const bool has_next = S.next(ui + 1, nxt);
        const char* nA = has_next ? (const char*)g.A + (size_t)nxt.pm * tstep : cA; const char* nB = has_next ? (const char*)g.Bt + (size_t)nxt.pn * tstep : cB;
        for (int t = 0; t < nt; t += 2) {
            const bool last = (t == nt - 2);
            const char* a1 = cA + (size_t)(t + 1) * kstep;
            const char* a2 = last ? nA : cA + (size_t)(t + 2) * kstep; const char* b2 = last ? nB : cB + (size_t)(t + 2) * kstep;
            const char* a3 = a2 + kstep; const char* b3 = b2 + kstep;
            if (last && has_next) S.a_ready(nxt);
            if constexpr (SP2) {
            PG8_LDB(B0, 0, 0); PG8_LDB(B1, 0, 1); PG8_SCHED; PG8_LDA(At, 0, 0); PG8_STAGE(PG8_SA(1, 1), a1 + hstep, voffA);
            PG8_WAIT_V(8); PG8_WAIT_L(0); PG8_BAR; PG8_MMA(0, 0, At, B0); PG8_MMA(0, 1, At, B1); PG8_BAR; PG8_SCHED;
            PG8_LDA(At, 0, 1); PG8_STAGE(PG8_SB(0, 0), b2, voffB); PG8_STAGE(PG8_SB(0, 1), b2 + hstep, voffB); PG8_STAGE(PG8_SA(0, 0), a2, voffA);
            PG8_WAIT_V(8); PG8_WAIT_L(0); PG8_BAR; PG8_MMA(1, 0, At, B0); PG8_MMA(1, 1, At, B1); PG8_BAR; PG8_SCHED;
            PG8_LDB(B0, 1, 0); PG8_LDB(B1, 1, 1); PG8_SCHED; PG8_LDA(At, 1, 0); PG8_STAGE(PG8_SA(0, 1), a2 + hstep, voffA);
            PG8_WAIT_V(8); PG8_WAIT_L(0); PG8_BAR; PG8_MMA(0, 0, At, B0); PG8_MMA(0, 1, At, B1); PG8_BAR; PG8_SCHED;
            PG8_LDA(At, 1, 1); PG8_STAGE(PG8_SB(1, 0), b3, voffB); PG8_STAGE(PG8_SB(1, 1), b3 + hstep, voffB); PG8_STAGE(PG8_SA(1, 0), a3, voffA);
            PG8_WAIT_V(8); PG8_WAIT_L(0); PG8_BAR; PG8_MMA(1, 0, At, B0); PG8_MMA(1, 1, At, B1); PG8_BAR; PG8_SCHED;
            } else {
            PG8_LDB(B0, 0, 0); PG8_SCHED; PG8_LDA(At, 0, 0); PG8_STAGE(PG8_SA(1, 1), a1 + hstep, voffA);
            PG8_WAIT_L(8); PG8_BAR; PG8_WAIT_L(0); PG8_MMA(0, 0, At, B0); PG8_BAR; PG8_SCHED;
            PG8_LDB(B1, 0, 1); PG8_STAGE(PG8_SB(0, 0), b2, voffB);
            PG8_BAR; PG8_WAIT_L(0); PG8_MMA(0, 1, At, B1); PG8_BAR;
            PG8_LDA(At, 0, 1); PG8_STAGE(PG8_SA(0, 0), a2, voffA);
            PG8_BAR; PG8_WAIT_L(0); PG8_MMA(1, 0, At, B0); PG8_BAR; PG8_SCHED;
            PG8_STAGE(PG8_SB(0, 1), b2 + hstep, voffB);
            PG8_WAIT_V(6); PG8_BAR; PG8_MMA(1, 1, At, B1); PG8_BAR;
            PG8_LDB(B0, 1, 0); PG8_SCHED; PG8_LDA(At, 1, 0); PG8_STAGE(PG8_SA(0, 1), a2 + hstep, voffA);
            PG8_WAIT_L(8); PG8_BAR; PG8_WAIT_L(0); PG8_MMA(0, 0, At, B0); PG8_BAR; PG8_SCHED;
            PG8_LDB(B1, 1, 1); PG8_STAGE(PG8_SB(1, 0), b3, voffB);
            PG8_BAR; PG8_WAIT_L(0); PG8_MMA(0, 1, At, B1); PG8_BAR;
            PG8_LDA(At, 1, 1); PG8_STAGE(PG8_SA(1, 0), a3, voffA);
            PG8_BAR; PG8_WAIT_L(0); PG8_MMA(1, 0, At, B0); PG8_BAR; PG8_SCHED;
            PG8_STAGE(PG8_SB(1, 1), b3 + hstep, voffB);
            PG8_WAIT_V(6); PG8_BAR; PG8_MMA(1, 1, At, B1); PG8_BAR;
            }
        }
        if constexpr (ALIGN_EPI) { if (wr == 0) PG8_BAR; }
        if constexpr (!Epi::AFTER_DRAIN) { E(acc, cur, wr, wc, fr, fq); S.done(cur); }
        if (!has_next) break;
        if constexpr (!Epi::KEEP_ACC) {
#pragma unroll
        for (int a = 0; a < 2; ++a)
#pragma unroll
            for (int b = 0; b < 2; ++b)
#pragma unroll
                for (int m = 0; m < 4; ++m)
#pragma unroll
                    for (int n = 0; n < 2; ++n) acc[a][b][m][n] = (f32x4){0.f, 0.f, 0.f, 0.f};
        }
        cur = nxt; cA = nA; cB = nB; ++ui;
        if constexpr (ALIGN_EPI) { if (wr == 1) PG8_BAR; }
    }
    PG8_WAIT_V(0);
    if constexpr (!ALIGN_EPI) { if (wr == 0) PG8_BAR; }
    PG8_BAR;
    if constexpr (Epi::AFTER_DRAIN) { E.fused(acc, cur, wr, wc, fr, fq, lds, wid, lane); S.done(cur); }
#undef PG8_SA
#undef PG8_SB
#undef PG8_STAGE
#undef PG8_LDA
#undef PG8_LDB
#undef PG8_MMA
#undef PG8_WAIT_V
#undef PG8_WAIT_L
#undef PG8_BAR
#undef PG8_SCHED
}
}

constexpr int NWAVES = 8;
constexpr int BATCH = 4, SEQ = 2048, D = 2048, DEPTH = 4, M = BATCH * SEQ;
constexpr int DFF = 5632, NH = 8, HD = 128, WIDE = 1024;
constexpr int IN_W = 14344, WIN_N = 14336;
constexpr int SRC_FQ = 1024, SRC_FLOGIT = 4096, SRC_RQ = 4104, SRC_RK = 5128, SRC_RV = 6152, SRC_RG = 7176, SRC_GATES = 8200;
#ifndef MK_PER_PHASE
#define MK_PER_PHASE 0
#endif
constexpr int N_PHASES = 2 + 8 * 2 + 4 * 4 + 1;

constexpr size_t MiB = 1u << 20;
constexpr size_t WS_CTL = 0, CTL_ZERO_BYTES = 1 * MiB;
constexpr size_t WS_WF = 1 * MiB;
constexpr size_t WS_COS = 2 * MiB, WS_SIN = 2 * MiB + 512 * 1024;
constexpr size_t WS_SS = 3 * MiB;
constexpr size_t WS_FL = 3 * MiB + 512 * 1024;
constexpr size_t WS_WP = 4 * MiB;
constexpr size_t WS_WBPT = 6 * MiB;
constexpr size_t WS_W13T = 32 * MiB,  SZ_W13T = (size_t)2 * DFF * D * 2;
constexpr size_t WS_W2T = WS_W13T + 8 * SZ_W13T, SZ_W2T = (size_t)D * DFF * 2;
constexpr size_t WS_WINT = WS_W2T + 8 * SZ_W2T, SZ_WINT = (size_t)WIN_N * D * 2;
constexpr size_t WS_WBR = WS_WINT + 4 * SZ_WINT, SZ_WBR = (size_t)3 * D * WIDE * 2;
constexpr size_t WS_WOUT = WS_WBR + 4 * SZ_WBR, SZ_WOUT = (size_t)D * D * 2;
constexpr size_t WS_X = WS_WOUT + 4 * SZ_WOUT;
constexpr size_t WS_XB = WS_X + (size_t)M * D * 4;
constexpr size_t WS_H = WS_XB + (size_t)M * D * 2;
constexpr size_t SZ_ACT = (size_t)M * WIDE * 2;
constexpr size_t WS_U = WS_H + (size_t)M * DFF * 2;
constexpr size_t WS_FQ = WS_U + SZ_ACT, WS_FK = WS_FQ + SZ_ACT, WS_FV = WS_FK + SZ_ACT, WS_RQ = WS_FV + SZ_ACT, WS_RK = WS_RQ + SZ_ACT, WS_RV = WS_RK + SZ_ACT, WS_RG = WS_RV + SZ_ACT;
constexpr size_t WS_GATES = WS_RG + SZ_ACT;
constexpr size_t WS_BRA = WS_GATES + (size_t)M * 6144 * 2;
constexpr size_t WS_MG = WS_BRA + 3 * SZ_ACT;
constexpr size_t WS_MGB = WS_MG + (size_t)M * D * 4;
constexpr size_t WS_END = WS_MGB + (size_t)M * D * 2;
static_assert(WS_W13T % 256 == 0 && SZ_W13T % 256 == 0 && SZ_W2T % 256 == 0 && SZ_WINT % 256 == 0 && WS_X % 256 == 0 && WS_END < (size_t)1700 * MiB, "d_ws map");
constexpr int CW_TMO = 0, CW_CODE = 1;
constexpr int CW_QUEUE = 64;
constexpr int CW_BAR = 4096;
constexpr int RING_OFF = 0, RING_BYTES = 131072;
constexpr int LDSCTL_OFF = RING_BYTES, MISC_OFF = LDSCTL_OFF + 320;
constexpr int LDS_BYTES = 147456;
static_assert(MISC_OFF + 128 <= LDS_BYTES, "LDS map");

#define GAS __attribute__((address_space(1)))
#define LAS __attribute__((address_space(3)))
typedef unsigned short bf16;
typedef unsigned v4u __attribute__((ext_vector_type(4)));
typedef unsigned v2u __attribute__((ext_vector_type(2)));
typedef float f32x4 __attribute__((ext_vector_type(4)));
typedef float f32x16 __attribute__((ext_vector_type(16)));
typedef short bf16x8 __attribute__((ext_vector_type(8)));
typedef short s16x4 __attribute__((ext_vector_type(4)));
typedef GAS unsigned gu32;
#define RLX_AGENT __ATOMIC_RELAXED, __HIP_MEMORY_SCOPE_AGENT
#define LDS_WAIT() asm volatile("s_waitcnt lgkmcnt(0)" ::: "memory")
#define VM_WAIT() asm volatile("s_waitcnt vmcnt(0)" ::: "memory")
__device__ __forceinline__ unsigned f2bf(float f) { unsigned u = __builtin_bit_cast(unsigned, f); return (u + 0x7fffu + ((u >> 16) & 1u)) >> 16; }
__device__ __forceinline__ unsigned pk2(float lo, float hi) { return f2bf(lo) | (f2bf(hi) << 16); }
__device__ __forceinline__ float bf2f(unsigned short h) { return __uint_as_float((unsigned)h << 16); }

#define XB_TMO      128
#define XB_XCNT(j)  (256  + 64 * (j))
#define XB_XSUB(j)  (1280 + 64 * (j))
#define XB_XGEN(j)  (2304 + 64 * (j))
#define XB_TOP      3328
#define XB_TOPGEN   3392
#define XCD_BAR_WORDS 3456
#define XB_SPIN_CAP (1u << 18)

__device__ __forceinline__ unsigned xb_ld(unsigned* p)              { return __hip_atomic_load(p, __ATOMIC_RELAXED, __HIP_MEMORY_SCOPE_AGENT); }
__device__ __forceinline__ unsigned xb_add(unsigned* p, unsigned v) { return __hip_atomic_fetch_add(p, v, __ATOMIC_RELAXED, __HIP_MEMORY_SCOPE_AGENT); }
__device__ __forceinline__ unsigned xb_xcc_id() { return (unsigned)__builtin_amdgcn_s_getreg((3 << 11) | 20) & 0xFu; }
#define XB_SPIN(cond, bar) do { unsigned _sp = 0; while (cond) { __builtin_amdgcn_s_sleep(1); \
    if ((++_sp & 255u) == 0u) { if (xb_ld(&(bar)[XB_TMO])) break; if (_sp > XB_SPIN_CAP) { atomicAdd(&(bar)[XB_TMO], 1u); break; } } } } while (0)

struct XcdBarrier {
    unsigned* bar; unsigned x;
    volatile LAS unsigned* st;
};

__device__ __forceinline__ XcdBarrier xcd_barrier_post(unsigned* bar, volatile LAS unsigned* st) {
    XcdBarrier b; b.bar = bar; b.x = xb_xcc_id(); b.st = st;
    if (threadIdx.x == 0) (void)xb_add(&bar[XB_XCNT(b.x)], 1u);
    return b;
}
__device__ __forceinline__ void xcd_barrier_complete(unsigned* bar, unsigned x, unsigned& nloc, unsigned& nx) {
    const unsigned G = gridDim.x * gridDim.y * gridDim.z;
    unsigned sum, cnt, mine, sp = 0u;
    for (;;) {
        sum = 0u; cnt = 0u; mine = 0u;
#pragma unroll
        for (unsigned j = 0; j < 16; ++j) { const unsigned c = xb_ld(&bar[XB_XCNT(j)]); sum += c; cnt += (c > 0u) ? 1u : 0u; mine = (j == x) ? c : mine; }
        if (sum == G) break;
        __builtin_amdgcn_s_sleep(1);
        if ((++sp & 255u) == 0u) { if (xb_ld(&bar[XB_TMO])) break; if (sp > XB_SPIN_CAP) { atomicAdd(&bar[XB_TMO], 1u); break; } }
    }
    nloc = mine > 0u ? mine : 1u; nx = cnt > 0u ? cnt : 1u;
}

__device__ __forceinline__ void xcd_barrier(const XcdBarrier& b) {
    asm volatile("s_waitcnt vmcnt(0)" ::: "memory");
    __syncthreads();
    if (threadIdx.x == 0) {
        unsigned* bar = b.bar;
        __builtin_amdgcn_s_waitcnt(0);
        unsigned nloc = b.st[0], nx = b.st[1];
        if (nloc == 0u) { xcd_barrier_complete(bar, b.x, nloc, nx); b.st[0] = nloc; b.st[1] = nx; }
        const unsigned old = xb_add(&bar[XB_XSUB(b.x)], 1u);
        const unsigned gen = old / nloc;
        if (old + 1u == (gen + 1u) * nloc) {
            __builtin_amdgcn_fence(__ATOMIC_RELEASE, "agent");
            asm volatile("s_waitcnt vmcnt(0)" ::: "memory");
            const unsigned og = xb_add(&bar[XB_TOP], 1u);
            const unsigned tg = og / nx;
            if (og + 1u == (tg + 1u) * nx) xb_add(&bar[XB_TOPGEN], 1u);
            else XB_SPIN(xb_ld(&bar[XB_TOPGEN]) == tg, bar);
            __builtin_amdgcn_fence(__ATOMIC_ACQUIRE, "agent");
            xb_add(&bar[XB_XGEN(b.x)], 1u);
            asm volatile("s_waitcnt vmcnt(0)" ::: "memory");
        } else {
            XB_SPIN(xb_ld(&bar[XB_XGEN(b.x)]) == gen, bar);
            __builtin_amdgcn_fence(__ATOMIC_ACQUIRE, "agent");
            asm volatile("s_waitcnt vmcnt(0)" ::: "memory");
        }
    }
    __syncthreads();
}

struct Args {
    const float* in[17];
    float* out; unsigned char* ws;
    int ph_lo, ph_hi, li, pad;
};
enum { I_X = 0, I_F1N, I_F1W13, I_F1W2, I_MIXN, I_WIN, I_FB, I_POOLW, I_POOLS, I_WBP, I_WBF, I_WBRT, I_WOUT, I_F2N, I_F2W13, I_F2W2, I_FINN };

__device__ __forceinline__ float wave_sum(float v) {
#pragma unroll
    for (int o = 1; o < 64; o <<= 1) v += __shfl_xor(v, o);
    return v;
}

struct TrItem { const float* p; const float* gain; bf16* dst0; size_t ldsrc, ldd; };
__device__ __forceinline__ void tr_load(const TrItem& t, float (&va)[32], float (&vb)[32], float& gv, int lane) {
#pragma unroll
    for (int i = 0; i < 32; ++i) { va[i] = t.p[(size_t)(2 * i) * t.ldsrc]; vb[i] = t.p[(size_t)(2 * i) * t.ldsrc + 32]; }
    gv = t.gain ? t.gain[lane] : 1.0f;
}
__device__ __forceinline__ void tr_store(const TrItem& t, const float (&va)[32], const float (&vb)[32], float gv, LAS float* scr, int lane) {
    const int c = lane & 7;
#pragma unroll
    for (int hh = 0; hh < 2; ++hh) {
#pragma unroll
        for (int i = 0; i < 32; ++i) { const float g0 = __builtin_bit_cast(float, __builtin_amdgcn_readlane(__builtin_bit_cast(int, gv), 2 * i)), g1 = __builtin_bit_cast(float, __builtin_amdgcn_readlane(__builtin_bit_cast(int, gv), 2 * i + 1));
            scr[(2 * i + (lane >> 5)) * 33 + (lane & 31)] = (hh ? vb[i] : va[i]) * ((lane >> 5) ? g1 : g0); }
        LDS_WAIT(); asm volatile("" ::: "memory");
#pragma unroll
        for (int j = 0; j < 4; ++j) { const int n = (lane >> 3) + 8 * j; const LAS float* s = scr + (8 * c) * 33 + n;
            v4u o; o.x = pk2(s[0 * 33], s[1 * 33]); o.y = pk2(s[2 * 33], s[3 * 33]); o.z = pk2(s[4 * 33], s[5 * 33]); o.w = pk2(s[6 * 33], s[7 * 33]);
            *(GAS v4u*)(t.dst0 + (size_t)(32 * hh + n) * t.ldd + 8 * c) = o; }
        LDS_WAIT(); asm volatile("" ::: "memory");
    }
}
__device__ __forceinline__ int win_src_col(int d0) {
    const int reg = d0 >> 10, w = d0 & 1023;
    if (reg < 4) return d0;
    if (reg == 4 || reg == 5) { const int pu = w >> 8, c = w & 255, head = 2 * pu + ((c & 127) >> 6), d = (c >> 7) * 64 + (c & 63); return (reg == 4 ? SRC_RQ : SRC_RK) + head * 128 + d; }
    if (reg == 6) return SRC_RV + w;
    if (reg == 7) return SRC_RG + w;
    return SRC_GATES + (d0 - 8192);
}
__device__ __forceinline__ void sincos_red(float a, float& sn, float& cs) {
    const double x = (double)a; const double q = __builtin_rint(x * 0.6366197723675814); const int n = (int)q;
    const float r = (float)(x - q * 1.5707963267948966), r2 = r * r;
    const float s = r + r * r2 * (-1.6666654611e-1f + r2 * (8.3321608736e-3f + r2 * (-1.9515295891e-4f)));
    const float c = 1.0f - 0.5f * r2 + r2 * r2 * (4.166664568298827e-2f + r2 * (-1.388731625493765e-3f + r2 * 2.443315711809948e-5f));
    switch (n & 3) { case 0: sn = s; cs = c; break; case 1: sn = c; cs = -s; break; case 2: sn = -s; cs = -c; break; default: sn = -c; cs = s; break; }
}


__device__ __forceinline__ void p0_prologue(const Args& args, LAS unsigned char* lds, int wave, int lane, int tid, int G) {
    unsigned char* ws = args.ws;
    LAS float* scr = (LAS float*)(lds + RING_OFF + wave * 16384);
    const int gw = (int)blockIdx.x * NWAVES + wave, NGW = G * NWAVES;
    constexpr int I_W13 = 32 * 176, I_W2 = 88 * 32, I_IN = 32 * 224, I_BR = 16 * 32, I_OUT = 32 * 32;
    constexpr int I_LAYER = 2 * I_W13 + 2 * I_W2 + I_IN + 3 * I_BR + I_OUT, I_ALL = DEPTH * I_LAYER;
#define TR_DECODE(it, T) do { \
        const int l = (it) / I_LAYER; int r = (it) % I_LAYER; \
        const float* src; size_t ldsrc; int k0, s0; const float* gain = nullptr; bf16* dst0; size_t ldd; \
        if (r < 2 * I_W13) { \
            const int f = r / I_W13; r %= I_W13; const int kb = r / 176, db = r % 176, d0 = 64 * db, pn = d0 >> 8, w = d0 & 255; \
            src = (f ? args.in[I_F2W13] : args.in[I_F1W13]) + (size_t)l * D * 2 * DFF; ldsrc = 2 * DFF; k0 = 64 * kb; s0 = (w >> 7) * DFF + pn * 128 + (w & 127); \
            gain = (f ? args.in[I_F2N] : args.in[I_F1N]) + l * D; dst0 = (bf16*)(ws + WS_W13T + (size_t)(2 * l + f) * SZ_W13T) + (size_t)d0 * D + k0; ldd = D; \
        } else if ((r -= 2 * I_W13) < 2 * I_W2) { \
            const int f = r / I_W2; r %= I_W2; const int kb = r / 32, db = r % 32; \
            src = (f ? args.in[I_F2W2] : args.in[I_F1W2]) + (size_t)l * DFF * D; ldsrc = D; k0 = 64 * kb; s0 = 64 * db; \
            dst0 = (bf16*)(ws + WS_W2T + (size_t)(2 * l + f) * SZ_W2T) + (size_t)s0 * DFF + k0; ldd = DFF; \
        } else if ((r -= 2 * I_W2) < I_IN) { \
            const int kb = r / 224, db = r % 224, d0 = 64 * db; \
            src = args.in[I_WIN] + (size_t)l * D * IN_W; ldsrc = IN_W; k0 = 64 * kb; s0 = win_src_col(d0); gain = args.in[I_MIXN] + l * D; \
            dst0 = (bf16*)(ws + WS_WINT + (size_t)l * SZ_WINT) + (size_t)d0 * D + k0; ldd = D; \
        } else if ((r -= I_IN) < 3 * I_BR) { \
            const int br = r / I_BR; r %= I_BR; const int kb = r / 32, db = r % 32; k0 = 64 * kb; s0 = 64 * db; ldsrc = D; \
            src = (br == 0 ? args.in[I_WBP] : br == 1 ? args.in[I_WBF] : args.in[I_WBRT]) + (size_t)l * WIDE * D; \
            if (br == 0) { gain = args.in[I_POOLS] + l * WIDE; \
                dst0 = (bf16*)(ws + WS_WBPT) + ((size_t)(l * 4 + (k0 >> 8)) * D + s0) * 256 + (k0 & 255); ldd = 256; } \
            else { dst0 = (bf16*)(ws + WS_WBR + (size_t)l * SZ_WBR) + (size_t)br * D * WIDE + (size_t)s0 * WIDE + k0; ldd = WIDE; } \
        } else { r -= 3 * I_BR; \
            const int kb = r / 32, db = r % 32; k0 = 64 * kb; s0 = 64 * db; ldsrc = D; \
            src = args.in[I_WOUT] + (size_t)l * D * D; dst0 = (bf16*)(ws + WS_WOUT + (size_t)l * SZ_WOUT) + (size_t)s0 * D + k0; ldd = D; \
        } \
        (T).p = src + (size_t)(k0 + (lane >> 5)) * ldsrc + s0 + (lane & 31); (T).gain = gain ? gain + k0 : nullptr; (T).dst0 = dst0; (T).ldsrc = ldsrc; (T).ldd = ldd; } while (0)
    {
        float vaA[32], vbA[32], vaB[32], vbB[32]; float gvA = 1.f, gvB = 1.f; TrItem tA, tB;
        int it = gw;
        if (it < I_ALL) { TR_DECODE(it, tA); tr_load(tA, vaA, vbA, gvA, lane); }
        for (; it < I_ALL; it += 2 * NGW) {
            const bool hasB = it + NGW < I_ALL, hasA2 = it + 2 * NGW < I_ALL;
            if (hasB) { TR_DECODE(it + NGW, tB); tr_load(tB, vaB, vbB, gvB, lane); }
            tr_store(tA, vaA, vbA, gvA, scr, lane);
            if (hasA2) { TR_DECODE(it + 2 * NGW, tA); tr_load(tA, vaA, vbA, gvA, lane); }
            if (hasB) tr_store(tB, vaB, vbB, gvB, scr, lane);
        }
    }
#undef TR_DECODE
    for (int m = gw; m < M; m += NGW) {
        const GAS f32x4* xr = (const GAS f32x4*)(args.in[I_X] + (size_t)m * D) + lane;
        GAS v2u* o8 = (GAS v2u*)((bf16*)(ws + WS_XB) + (size_t)m * D) + lane; float s = 0.f;
#pragma unroll
        for (int j = 0; j < 8; ++j) { const f32x4 v = xr[64 * j]; s += (v.x * v.x + v.y * v.y) + (v.z * v.z + v.w * v.w); v2u w; w.x = pk2(v.x, v.y); w.y = pk2(v.z, v.w); o8[64 * j] = w; }
        s = wave_sum(s);
        if (lane < 8) ((float*)(ws + WS_SS))[(size_t)m * 8 + lane] = lane == 0 ? s : 0.f;
    }
    const int gt = (int)blockIdx.x * (NWAVES * 64) + tid, NGT = G * NWAVES * 64;
    for (int i = gt; i < SEQ * 64; i += NGT) {
        const int t = i >> 6, j = i & 63; const float inv = powf(10000.0f, -(float)j / 64.0f); float sn, cs; sincos_red((float)t * inv, sn, cs);
        ((float*)(ws + WS_COS))[i] = cs; ((float*)(ws + WS_SIN))[i] = sn; }
    for (int i = gt; i < DEPTH * 4 * 256 * 256; i += NGT) ((bf16*)(ws + WS_WP))[i] = (bf16)f2bf(args.in[I_POOLW][i]);
    for (int i = gt; i < DEPTH * 8 * D; i += NGT) {
        const int l = i / (8 * D), h = (i / D) & 7, k = i % D;
        ((float*)(ws + WS_WF))[i] = args.in[I_WIN][(size_t)l * D * IN_W + (size_t)k * IN_W + SRC_FLOGIT + h] * args.in[I_MIXN][l * D + k]; }
}

__device__ __forceinline__ void flogit_rows(unsigned char* ws, int l, int wave, int lane) {
    const float* X = (const float*)(ws + WS_X); const float* WF = (const float*)(ws + WS_WF) + (size_t)l * 8 * D; const float* ss = (const float*)(ws + WS_SS); float* FL = (float*)(ws + WS_FL);
    const int row0 = (int)blockIdx.x * 32 + wave * 4;
    float acc[4][8];
#pragma unroll
    for (int r = 0; r < 4; ++r)
#pragma unroll
        for (int h = 0; h < 8; ++h) acc[r][h] = 0.f;
#pragma unroll 2
    for (int j = 0; j < 8; ++j) {
        f32x4 wv[8], xv[4];
#pragma unroll
        for (int h = 0; h < 8; ++h) wv[h] = *(const f32x4*)(WF + h * D + 256 * j + 4 * lane);
#pragma unroll
        for (int r = 0; r < 4; ++r) xv[r] = *(const f32x4*)(X + (size_t)(row0 + r) * D + 256 * j + 4 * lane);
#pragma unroll
        for (int r = 0; r < 4; ++r)
#pragma unroll
            for (int h = 0; h < 8; ++h) acc[r][h] += (xv[r].x * wv[h].x + xv[r].y * wv[h].y) + (xv[r].z * wv[h].z + xv[r].w * wv[h].w);
    }
#pragma unroll
    for (int r = 0; r < 4; ++r) { const float rs = pg8::row_rstd(ss, row0 + r);
#pragma unroll
        for (int h = 0; h < 8; ++h) { const float s = wave_sum(acc[r][h]); if (lane == h) FL[(size_t)(row0 + r) * 8 + h] = s * rs; } }
}

__device__ __forceinline__ unsigned off_a(unsigned row, unsigned ch) { return 2048u * (row >> 3) + 512u * (ch >> 2) + 64u * (row & 7u) + 16u * ((ch & 3u) ^ ((row >> 2) & 3u)); }
typedef short v4i16_t __attribute__((ext_vector_type(4)));
__device__ __forceinline__ s16x4 vtr(const LAS unsigned char* p) { return __builtin_bit_cast(s16x4, __builtin_amdgcn_ds_read_tr16_b64_v4i16((LAS v4i16_t*)p)); }
__device__ __forceinline__ int crow(int r, int hi) { return (r & 3) + 8 * (r >> 2) + 4 * hi; }
constexpr int AT_HALF = 65536, AT_K0 = 0, AT_V0 = 32768;
constexpr int AT_NLB = LDSCTL_OFF + 1024, AT_WTOT = AT_NLB + 8192;
static_assert(AT_WTOT + 64 <= LDS_BYTES, "mixer LDS map");
constexpr float LOG2E_F = 1.4426950408889634f;

__device__ __forceinline__ void mix_nlb(unsigned char* ws, const float* fbias_l, LAS unsigned char* lds, int b, int h, int wave, int lane, int tid) {
    LAS float* nlb = (LAS float*)(lds + AT_NLB);
    __syncthreads();
    {
        const float* FL = (const float*)(ws + WS_FL) + (size_t)b * SEQ * 8 + h; const float fb = fbias_l[h];
        float v[4]; float s = 0.f;
#pragma unroll
        for (int e = 0; e < 4; ++e) { const float z = FL[(size_t)(4 * tid + e) * 8] + fb; v[e] = (fminf(z, 0.f) - log1pf(expf(-fabsf(z)))) * LOG2E_F; s += v[e]; }
        float sc = s;
#pragma unroll
        for (int o = 1; o < 64; o <<= 1) { const float t = __shfl_up(sc, o); if (lane >= o) sc += t; }
        LAS float* wtot = (LAS float*)(lds + AT_WTOT);
        if (lane == 63) wtot[wave] = sc;
        __syncthreads();
        float pre = 0.f;
        for (int w = 0; w < wave; ++w) pre += wtot[w];
        float run = pre + (sc - s);
#pragma unroll
        for (int e = 0; e < 4; ++e) { run += v[e]; nlb[4 * tid + e] = -run; }
    }
}
template <int MODE>
__device__ __forceinline__ void mix_half(unsigned char* ws, LAS unsigned char* lds_all, int b, int h, int qb, int wave, int lane) {
    LAS unsigned char* lds = lds_all + MODE * AT_HALF;
    const LAS float* nlb = (const LAS float*)(lds_all + AT_NLB);
    const int q = lane & 31, hi = lane >> 5;
    const int R0 = 128 * qb + 32 * wave, tq = R0 + q;
    const size_t rowbase = (size_t)b * SEQ;
    const bf16* Qg = (const bf16*)(ws + (MODE ? WS_RQ : WS_FQ)) + (rowbase + tq) * WIDE + h * HD;
    const bf16* Kg = (const bf16*)(ws + (MODE ? WS_RK : WS_FK)) + rowbase * WIDE + h * HD;
    const bf16* Vg = (const bf16*)(ws + (MODE ? WS_RV : WS_FV)) + rowbase * WIDE + h * HD;
    const int nt = 2 * (qb + 1);
    bf16x8 qf[8];
#pragma unroll
    for (int s = 0; s < 8; ++s) qf[s] = *(const bf16x8*)(Qg + 16 * s + 8 * hi);
    f32x16 o[4];
#pragma unroll
    for (int c = 0; c < 4; ++c)
#pragma unroll
        for (int r = 0; r < 16; ++r) o[c][r] = 0.f;
    float mrun = -1e30f, lrun = 0.f;
    unsigned stoff0;
    { const unsigned p = (unsigned)(wave * 64 + lane), row = ((p >> 7) << 3) | ((p >> 2) & 7u), ch = (((p >> 5) & 3u) << 2) | ((p & 3u) ^ ((row >> 2) & 3u)); stoff0 = row * WIDE + ch * 8u; }
#define AT_STAGE(jt, buf) do { _Pragma("unroll") for (int _i = 0; _i < 4; ++_i) { \
        __builtin_amdgcn_global_load_lds((const unsigned*)(Kg + (size_t)(64 * (jt) + 16 * _i) * WIDE + stoff0), (LAS unsigned*)(lds + AT_K0 + (buf) * 16384 + (4 * _i + wave) * 1024), 16, 0, 0); \
        __builtin_amdgcn_global_load_lds((const unsigned*)(Vg + (size_t)(64 * (jt) + 16 * _i) * WIDE + stoff0), (LAS unsigned*)(lds + AT_V0 + (buf) * 16384 + (4 * _i + wave) * 1024), 16, 0, 0); } } while (0)
    AT_STAGE(nt - 1, 0);
    asm volatile("s_waitcnt vmcnt(0)" ::: "memory");
    __syncthreads();
    unsigned kbase[2], vbase[2];
#pragma unroll
    for (int e = 0; e < 2; ++e) { kbase[e] = 2048u * ((unsigned)q >> 3) + 64u * ((unsigned)q & 7u) + 16u * ((unsigned)(2 * e + hi) ^ (((unsigned)q >> 2) & 3u)); }
    const unsigned tq_ = (unsigned)(lane & 15) >> 2, tp = (unsigned)lane & 3u, tblk = ((unsigned)lane >> 4) & 1u;
#pragma unroll
    for (int t = 0; t < 2; ++t) vbase[t] = 64u * (4u * hi + tq_) + 16u * ((2u * tblk + (tp >> 1)) ^ ((unsigned)(2 * t + hi) & 3u)) + 8u * (tp & 1u);
    for (int j = 0; j < nt; ++j) {
        const int cur = j & 1, jt = nt - 1 - j; const bool more = (j + 1 < nt);
        if (more) AT_STAGE(jt - 1, cur ^ 1);
        const bool active = (64 * jt <= R0 + 31);
        if (active) {
            const LAS unsigned char* Kt = lds + AT_K0 + cur * 16384; const LAS unsigned char* Vt = lds + AT_V0 + cur * 16384;
            f32x16 s0, s1;
            if (MODE == 0) {
#pragma unroll
                for (int g = 0; g < 4; ++g) { const f32x4 a = *(const LAS f32x4*)(nlb + 64 * jt + 8 * g + 4 * hi), c = *(const LAS f32x4*)(nlb + 64 * jt + 32 + 8 * g + 4 * hi);
#pragma unroll
                    for (int e = 0; e < 4; ++e) { s0[4 * g + e] = a[e]; s1[4 * g + e] = c[e]; } }
            } else {
#pragma unroll
                for (int r = 0; r < 16; ++r) { s0[r] = 0.f; s1[r] = 0.f; }
            }
            {
                bf16x8 kf[16];
#pragma unroll
                for (int s = 0; s < 8; ++s) { const unsigned a = kbase[s & 1] + 512u * (unsigned)(s >> 1);
                    kf[2 * s] = *(const LAS bf16x8*)(Kt + a); kf[2 * s + 1] = *(const LAS bf16x8*)(Kt + a + 8192); }
                __builtin_amdgcn_sched_barrier(0);
#pragma unroll
                for (int s = 0; s < 8; ++s) {
                    s0 = __builtin_amdgcn_mfma_f32_32x32x16_bf16(kf[2 * s], qf[s], s0, 0, 0, 0);
                    s1 = __builtin_amdgcn_mfma_f32_32x32x16_bf16(kf[2 * s + 1], qf[s], s1, 0, 0, 0);
                }
            }
            s16x4 vv[4][2][2][2];
#pragma unroll
            for (int c = 0; c < 2; ++c)
#pragma unroll
                for (int blk = 0; blk < 2; ++blk)
#pragma unroll
                    for (int st = 0; st < 2; ++st)
#pragma unroll
                        for (int t = 0; t < 2; ++t) vv[c][blk][st][t] = vtr(Vt + vbase[t] + 2048u * (unsigned)(4 * blk + 2 * st + t) + 512u * (unsigned)c);
            __builtin_amdgcn_sched_barrier(0);
            if (64 * jt + 63 > R0) {
                const float NEG = MODE == 0 ? -__builtin_inff() : 0.f;
#pragma unroll
                for (int r = 0; r < 16; ++r) { const int key = 64 * jt + crow(r, hi); if (key > tq) s0[r] = NEG; if (key + 32 > tq) s1[r] = NEG; }
            }
            if (MODE == 0) {
                float pmax = s0[0];
#pragma unroll
                for (int r = 1; r < 16; ++r) pmax = fmaxf(pmax, s0[r]);
#pragma unroll
                for (int r = 0; r < 16; ++r) pmax = fmaxf(pmax, s1[r]);
                pmax = fmaxf(pmax, __shfl_xor(pmax, 32));
                const float mn = fmaxf(mrun, pmax);
                if (__any(mn > mrun)) {
                    const float alpha = __builtin_amdgcn_exp2f(mrun - mn); mrun = mn; lrun *= alpha;
#pragma unroll
                    for (int c = 0; c < 4; ++c)
#pragma unroll
                        for (int r = 0; r < 16; ++r) o[c][r] *= alpha;
                }
                float rs = 0.f;
#pragma unroll
                for (int r = 0; r < 16; ++r) { s0[r] = __builtin_amdgcn_exp2f(s0[r] - mrun); s1[r] = __builtin_amdgcn_exp2f(s1[r] - mrun); rs += s0[r] + s1[r]; }
                lrun += rs;
            }
            bf16x8 pf[2][2];
#pragma unroll
            for (int st = 0; st < 2; ++st) {
                v4u w0, w1;
                w0.x = pg8::cvt_pk_bf16(s0[8 * st + 0], s0[8 * st + 1]); w0.y = pg8::cvt_pk_bf16(s0[8 * st + 2], s0[8 * st + 3]); w0.z = pg8::cvt_pk_bf16(s0[8 * st + 4], s0[8 * st + 5]); w0.w = pg8::cvt_pk_bf16(s0[8 * st + 6], s0[8 * st + 7]);
                w1.x = pg8::cvt_pk_bf16(s1[8 * st + 0], s1[8 * st + 1]); w1.y = pg8::cvt_pk_bf16(s1[8 * st + 2], s1[8 * st + 3]); w1.z = pg8::cvt_pk_bf16(s1[8 * st + 4], s1[8 * st + 5]); w1.w = pg8::cvt_pk_bf16(s1[8 * st + 6], s1[8 * st + 7]);
                pf[0][st] = __builtin_bit_cast(bf16x8, w0); pf[1][st] = __builtin_bit_cast(bf16x8, w1);
            }
#pragma unroll
            for (int c = 2; c < 4; ++c)
#pragma unroll
                for (int blk = 0; blk < 2; ++blk)
#pragma unroll
                    for (int st = 0; st < 2; ++st)
#pragma unroll
                        for (int t = 0; t < 2; ++t) vv[c][blk][st][t] = vtr(Vt + vbase[t] + 2048u * (unsigned)(4 * blk + 2 * st + t) + 512u * (unsigned)c);
            __builtin_amdgcn_sched_barrier(0);
#pragma unroll
            for (int c = 0; c < 4; ++c)
#pragma unroll
                for (int blk = 0; blk < 2; ++blk)
#pragma unroll
                    for (int st = 0; st < 2; ++st) {
                        const s16x4 v0 = vv[c][blk][st][0], v1 = vv[c][blk][st][1];
                        bf16x8 vf; vf[0] = v0[0]; vf[1] = v0[1]; vf[2] = v0[2]; vf[3] = v0[3]; vf[4] = v1[0]; vf[5] = v1[1]; vf[6] = v1[2]; vf[7] = v1[3];
                        o[c] = __builtin_amdgcn_mfma_f32_32x32x16_bf16(vf, pf[blk][st], o[c], 0, 0, 0);
                    }
        }
        asm volatile("s_waitcnt vmcnt(0)" ::: "memory");
        __syncthreads();
    }
#undef AT_STAGE
    bf16* Yg = (bf16*)(ws + WS_BRA + (MODE ? 2 : 1) * SZ_ACT) + (rowbase + tq) * WIDE + h * HD;
    if (MODE == 0) {
        const float lt = lrun + __shfl_xor(lrun, 32), inv = 1.0f / lt;
#pragma unroll
        for (int c = 0; c < 4; ++c)
#pragma unroll
            for (int g = 0; g < 4; ++g) { v2u w; w.x = pg8::cvt_pk_bf16(o[c][4 * g] * inv, o[c][4 * g + 1] * inv); w.y = pg8::cvt_pk_bf16(o[c][4 * g + 2] * inv, o[c][4 * g + 3] * inv);
                *(GAS v2u*)(Yg + 32 * c + 8 * g + 4 * hi) = w; }
    } else {
        float sm = 0.f;
#pragma unroll
        for (int c = 0; c < 4; ++c)
#pragma unroll
            for (int r = 0; r < 16; ++r) sm += o[c][r];
        sm += __shfl_xor(sm, 32);
        const float mu = sm * (1.0f / 128.0f); float vs = 0.f;
#pragma unroll
        for (int c = 0; c < 4; ++c)
#pragma unroll
            for (int r = 0; r < 16; ++r) { const float d = o[c][r] - mu; vs += d * d; }
        vs += __shfl_xor(vs, 32);
        const float rstd = 1.0f / sqrtf(vs * (1.0f / 128.0f) + 1e-5f);
        const bf16* Gg = (const bf16*)(ws + WS_RG) + (rowbase + tq) * WIDE + h * HD;
#pragma unroll
        for (int c = 0; c < 4; ++c)
#pragma unroll
            for (int g = 0; g < 4; ++g) { const v2u gw = *(const GAS v2u*)(Gg + 32 * c + 8 * g + 4 * hi);
                const float g0 = __uint_as_float(gw.x << 16), g1 = __uint_as_float(gw.x & 0xffff0000u), g2 = __uint_as_float(gw.y << 16), g3 = __uint_as_float(gw.y & 0xffff0000u);
                v2u w; w.x = pg8::cvt_pk_bf16((o[c][4 * g] - mu) * rstd * g0, (o[c][4 * g + 1] - mu) * rstd * g1); w.y = pg8::cvt_pk_bf16((o[c][4 * g + 2] - mu) * rstd * g2, (o[c][4 * g + 3] - mu) * rstd * g3);
                *(GAS v2u*)(Yg + 32 * c + 8 * g + 4 * hi) = w; }
    }
}

__device__ __forceinline__ void mix_unit(unsigned char* ws, const float* fbias_l, LAS unsigned char* lds, int b, int h, int qb, int wave, int lane, int tid) {
    mix_nlb(ws, fbias_l, lds, b, h, wave, lane, tid);
    if (wave < 4) mix_half<0>(ws, lds, b, h, qb, wave, lane); else mix_half<1>(ws, lds, b, h, qb, wave - 4, lane);
}

__device__ __forceinline__ void unpack8(const v4u x, float (&f)[8]) {
    f[0] = __uint_as_float(x.x << 16); f[1] = __uint_as_float(x.x & 0xffff0000u); f[2] = __uint_as_float(x.y << 16); f[3] = __uint_as_float(x.y & 0xffff0000u);
    f[4] = __uint_as_float(x.z << 16); f[5] = __uint_as_float(x.z & 0xffff0000u); f[6] = __uint_as_float(x.w << 16); f[7] = __uint_as_float(x.w & 0xffff0000u); }
template <int W>
__device__ __forceinline__ void pool_rows(const bf16* U, bf16* P, int r0, int c0) {
    const int t0 = r0 & (SEQ - 1);
    v4u x[7 + W];
#pragma unroll
    for (int i = 0; i < 7 + W; ++i) { const int dr = i - (W - 1); x[i] = (t0 + dr >= 0) ? *(const GAS v4u*)(U + (size_t)(r0 + dr) * WIDE + c0) : (v4u){0u, 0u, 0u, 0u}; }
    float s[8];
#pragma unroll
    for (int e = 0; e < 8; ++e) s[e] = 0.f;
#pragma unroll
    for (int i = 0; i < W - 1; ++i) { float f[8]; unpack8(x[i], f);
#pragma unroll
        for (int e = 0; e < 8; ++e) s[e] += f[e]; }
#pragma unroll
    for (int i = 0; i < 8; ++i) {
        float cur[8]; unpack8(x[W - 1 + i], cur);
#pragma unroll
        for (int e = 0; e < 8; ++e) s[e] += cur[e];
        const int t = t0 + i; const float ic = 1.0f / (float)((t + 1 < W) ? t + 1 : W);
        v4u o; o.x = pk2(s[0] * ic - cur[0], s[1] * ic - cur[1]); o.y = pk2(s[2] * ic - cur[2], s[3] * ic - cur[3]); o.z = pk2(s[4] * ic - cur[4], s[5] * ic - cur[5]); o.w = pk2(s[6] * ic - cur[6], s[7] * ic - cur[7]);
        *(GAS v4u*)(P + (size_t)(r0 + i) * WIDE + c0) = o;
        float old[8]; unpack8(x[i], old);
#pragma unroll
        for (int e = 0; e < 8; ++e) s[e] -= old[e];
    }
}
__device__ __forceinline__ void pool_item(unsigned char* ws, int item, int wave, int lane) {
    const bf16* U = (const bf16*)(ws + WS_U); bf16* P = (bf16*)(ws + WS_BRA);
    const int g = wave & 3, c0 = g * 256 + (lane & 31) * 8, r0 = item * 64 + ((wave >> 2) * 2 + (lane >> 5)) * 16;
#pragma unroll 1
    for (int hp = 0; hp < 2; ++hp) { const int r = r0 + 8 * hp;
        if (g == 0) pool_rows<2>(U, P, r, c0); else if (g == 1) pool_rows<4>(U, P, r, c0); else if (g == 2) pool_rows<8>(U, P, r, c0); else pool_rows<16>(U, P, r, c0); }
}

__global__ void __launch_bounds__(NWAVES * 64, 2) mk_fwd(Args args) {
    extern __shared__ __attribute__((aligned(16))) unsigned char lds_raw[];
    LAS unsigned char* lds = (LAS unsigned char*)lds_raw;
    volatile LAS unsigned* MISC = (volatile LAS unsigned*)(lds + MISC_OFF);
    const int tid0 = threadIdx.x;
#define OPAQUE_TID() int tid = tid0; asm volatile("" : "+v"(tid)); const int lane = tid & 63, wave = __builtin_amdgcn_readfirstlane(tid >> 6); (void)lane; (void)wave
    const int G = gridDim.x;
    unsigned char* ws = args.ws;
    gu32* ctl = (gu32*)(ws + WS_CTL);
    for (int u = tid0; u < (LDS_BYTES - LDSCTL_OFF) / 4; u += NWAVES * 64) ((LAS unsigned*)(lds + LDSCTL_OFF))[u] = 0u;
    __syncthreads();
#if MK_PER_PHASE
    XcdBarrier bar; bar.bar = (unsigned*)(ctl + CW_BAR); bar.x = 0; bar.st = nullptr;
#define GRID_BAR() do { if (tid0 == 0) __hip_atomic_store(ctl + CW_TMO, 0xBADBA0u, RLX_AGENT); } while (0)
#else
    XcdBarrier bar = xcd_barrier_post((unsigned*)(ctl + CW_BAR), MISC + 8);
#define GRID_BAR() xcd_barrier(bar)
#endif
    const int lo = args.ph_lo, hi = args.ph_hi;
    int p = 0;
#define IN(k) (lo <= (k) && (k) < hi)
#ifndef MK_OFF
#define MK_OFF 0
#endif
#define PH_ON(n) (!((MK_OFF) & (1 << (n))))
#ifndef MK_DUP
#define MK_DUP 0
#endif
#define NREP(n) ((((MK_DUP) >> (n)) & 1) ? 2 : 1)
#ifndef MK_BAR2
#define MK_BAR2 0
#endif
#define SEAM() do { if (IN(p) && IN(p + 1)) { GRID_BAR(); if (MK_BAR2) GRID_BAR(); } ++p; } while (0)

    bf16* XB = (bf16*)(ws + WS_XB); float* X = (float*)(ws + WS_X); float* SS = (float*)(ws + WS_SS);

    if (PH_ON(0) && IN(p)) for (int rep = 0; rep < NREP(0); ++rep) { OPAQUE_TID(); p0_prologue(args, lds, wave, lane, tid, G); if (rep + 1 < NREP(0)) GRID_BAR(); }
    SEAM();

    if (PH_ON(8) && IN(p)) {
        pg8::Gemm g{(const bf16*)(ws + WS_WBPT), (const bf16*)(ws + WS_WP), 16 * D, 16 * 256, 256}; pg8::FoldOrder S{(int)blockIdx.x};
        pg8::EpiFold E{(bf16*)(ws + WS_WBR), SZ_WBR / 2};
        for (int rep = 0; rep < NREP(8); ++rep) { pg8::gemm_phase<pg8::EpiFold, pg8::FoldOrder, false, true>(lds + RING_OFF, g, S, E); if (rep + 1 < NREP(8)) GRID_BAR(); }
    }
    SEAM();

    for (int j = 0; j < 2 * DEPTH; ++j) {
        const int l = j >> 1;
        if (PH_ON(1) && IN(p)) {
            pg8::Gemm g{XB, (const bf16*)(ws + WS_W13T + (size_t)j * SZ_W13T), M, 2 * DFF, D}; pg8::StaticOrder S; S.init(M, 2 * DFF, G, (int)blockIdx.x);
            pg8::EpiSwiGLU E{(bf16*)(ws + WS_H), SS, DFF};
            for (int rep = 0; rep < NREP(1); ++rep) { pg8::gemm_phase<pg8::EpiSwiGLU, pg8::StaticOrder, true, true>(lds + RING_OFF, g, S, E); if (rep + 1 < NREP(1)) GRID_BAR(); }
        }
        SEAM();
        if (PH_ON(2) && IN(p)) {
            pg8::Gemm g{(const bf16*)(ws + WS_H), (const bf16*)(ws + WS_W2T + (size_t)j * SZ_W2T), M, D, DFF}; pg8::StaticOrder S; S.init(M, D, G, (int)blockIdx.x);
            for (int rep = 0; rep < NREP(2); ++rep) { pg8::EpiResid E{j == 0 ? args.in[I_X] : (const float*)X, X, XB, SS, rep + 1 < NREP(2) ? 0.0f : 0.5f};
                pg8::gemm_phase<pg8::EpiResid, pg8::StaticOrder, false, true>(lds + RING_OFF, g, S, E); if (rep + 1 < NREP(2)) GRID_BAR(); }
        }
        SEAM();
        if (j & 1) continue;
        if (PH_ON(3) && IN(p)) {
            for (int rep = 0; rep < NREP(9); ++rep) { OPAQUE_TID(); flogit_rows(ws, l, wave, lane); }
            pg8::Gemm g{XB, (const bf16*)(ws + WS_WINT + (size_t)l * SZ_WINT), M, WIN_N, D}; pg8::StaticOrder S; S.init(M, WIN_N, G, (int)blockIdx.x);
            pg8::EpiWin E{SS, (bf16*)(ws + WS_U), (bf16*)(ws + WS_FQ), (bf16*)(ws + WS_FK), (bf16*)(ws + WS_FV), (bf16*)(ws + WS_RQ), (bf16*)(ws + WS_RK), (bf16*)(ws + WS_RV), (bf16*)(ws + WS_RG), (bf16*)(ws + WS_GATES),
                          (const float*)(ws + WS_COS), (const float*)(ws + WS_SIN)};
            for (int rep = 0; rep < NREP(3); ++rep) { pg8::gemm_phase<pg8::EpiWin, pg8::StaticOrder, true, true>(lds + RING_OFF, g, S, E); if (rep + 1 < NREP(3)) GRID_BAR(); }
        }
        SEAM();
        if (PH_ON(4) && IN(p)) {
            OPAQUE_TID();
            const float* fb = args.in[I_FB] + l * NH;
            for (int rep = 0; rep < NREP(4); ++rep) {
            gu32* head = ctl + CW_QUEUE + 64 * l + 512 * rep;
            for (;;) {
                __syncthreads();
                if (tid == 0) MISC[0] = __hip_atomic_fetch_add(head, 1u, RLX_AGENT);
                __syncthreads();
                const int it = (int)MISC[0];
                if (it >= 512 + 128) break;
                if (it < 512) { const int qb = 15 - (it >> 5), bh = it & 31; mix_unit(ws, fb, lds, bh >> 3, bh & 7, qb, wave, lane, tid); }
                else pool_item(ws, it - 512, wave, lane);
            }
            if (rep + 1 < NREP(4)) GRID_BAR(); }
        }
        SEAM();
        if (PH_ON(5) && IN(p)) {
            pg8::Gemm g{(const bf16*)(ws + WS_BRA), (const bf16*)(ws + WS_WBR + (size_t)l * SZ_WBR), 3 * M, 3 * D, WIDE}; pg8::BranchOrder S; S.so.init(M, D, G, (int)blockIdx.x);
            pg8::EpiBranch E{(const bf16*)(ws + WS_GATES), (bf16*)(ws + WS_MGB)};
            for (int rep = 0; rep < NREP(5); ++rep) { pg8::gemm_phase<pg8::EpiBranch, pg8::BranchOrder, true, true>(lds + RING_OFF, g, S, E); if (rep + 1 < NREP(5)) GRID_BAR(); }
        }
        SEAM();
        if (PH_ON(6) && IN(p)) {
            pg8::Gemm g{(const bf16*)(ws + WS_MGB), (const bf16*)(ws + WS_WOUT + (size_t)l * SZ_WOUT), M, D, D}; pg8::StaticOrder S; S.init(M, D, G, (int)blockIdx.x);
            for (int rep = 0; rep < NREP(6); ++rep) { pg8::EpiResid E{(const float*)X, X, XB, SS, rep + 1 < NREP(6) ? 0.0f : 1.0f};
                pg8::gemm_phase<pg8::EpiResid, pg8::StaticOrder, false, true>(lds + RING_OFF, g, S, E); if (rep + 1 < NREP(6)) GRID_BAR(); }
        }
        SEAM();
    }
    if (PH_ON(7) && IN(p)) {
        OPAQUE_TID();
        const unsigned bad = __hip_atomic_load(ctl + CW_TMO, RLX_AGENT) | __hip_atomic_load(ctl + CW_BAR + XB_TMO, RLX_AGENT);
        const float* gf = args.in[I_FINN];
        for (int rep = 0; rep < NREP(7); ++rep)
        for (int m = (int)blockIdx.x * NWAVES + wave; m < M; m += G * NWAVES) {
            const float rs = bad ? __builtin_nanf("") : pg8::row_rstd(SS, m);
            const GAS f32x4* xr = (const GAS f32x4*)(X + (size_t)m * D) + lane; GAS f32x4* orow = (GAS f32x4*)(args.out + (size_t)m * D) + lane;
#pragma unroll
            for (int k = 0; k < 8; ++k) { const f32x4 v = xr[64 * k], gv = *((const GAS f32x4*)gf + lane + 64 * k); orow[64 * k] = v * rs * gv; }
        }
    }
#undef IN
#undef SEAM
#undef GRID_BAR
}

extern "C" void kernel_launch(void* const* d_in, const int* in_sizes, int n_in, void* d_out, int out_size, void* d_ws, size_t ws_size, hipStream_t stream) {
    static int grid = 0;
    if (grid == 0) {
        if (n_in != 17 || in_sizes[0] != M * D || out_size != M * D || ws_size < WS_END) { fprintf(stderr, "kernel_launch: unexpected shapes (n_in %d, in0 %d, out %d, ws %zu < %zu); nothing launched\n", n_in, n_in > 0 ? in_sizes[0] : -1, out_size, ws_size, (size_t)WS_END); grid = -1; return; }
        int dev = 0, cus = 0, per_cu = 0;
        if (hipGetDevice(&dev) != hipSuccess || hipDeviceGetAttribute(&cus, hipDeviceAttributeMultiprocessorCount, dev) != hipSuccess) { grid = -1; return; }
        if (hipFuncSetAttribute((const void*)mk_fwd, hipFuncAttributeMaxDynamicSharedMemorySize, LDS_BYTES) != hipSuccess) { fprintf(stderr, "kernel_launch: hipFuncSetAttribute failed\n"); grid = -1; return; }
        if (hipOccupancyMaxActiveBlocksPerMultiprocessor(&per_cu, (const void*)mk_fwd, NWAVES * 64, LDS_BYTES) != hipSuccess || per_cu < 1) { fprintf(stderr, "kernel_launch: occupancy query says %d workgroups per CU\n", per_cu); }
        (void)hipGetLastError();
        if (cus != 256) { fprintf(stderr, "kernel_launch: built for 256 CUs, device has %d; nothing launched\n", cus); grid = -1; return; }
        grid = 256;
    }
    if (grid < 0) return;
    if (hipMemsetAsync((char*)d_ws + WS_CTL, 0, CTL_ZERO_BYTES, stream) != hipSuccess) return;
    Args a{};
    for (int i = 0; i < 17; ++i) a.in[i] = (const float*)d_in[i];
    a.out = (float*)d_out; a.ws = (unsigned char*)d_ws;
#if MK_PER_PHASE
    for (int li = 0; li < N_PHASES; ++li) { a.ph_lo = li; a.ph_hi = li + 1; a.li = li; hipLaunchKernelGGL(mk_fwd, dim3(grid), dim3(NWAVES * 64), LDS_BYTES, stream, a); }
#else
    a.ph_lo = 0; a.ph_hi = N_PHASES; a.li = 0;
    hipLaunchKernelGGL(mk_fwd, dim3(grid), dim3(NWAVES * 64), LDS_BYTES, stream, a);
#endif
    const hipError_t le = hipPeekAtLastError();
    if (le != hipSuccess) fprintf(stderr, "kernel_launch: launch failed: %s\n", hipGetErrorName(le));
}
```

```cpp
#include <hip/hip_runtime.h>
#include <cstdio>
#include <cstdint>
#include <cmath>
namespace pg8 {
#define PG8_LAS __attribute__((address_space(3)))
typedef unsigned short bf16_t;
typedef short bf16x8 __attribute__((ext_vector_type(8)));
typedef float f32x4 __attribute__((ext_vector_type(4)));
typedef unsigned u32x4 __attribute__((ext_vector_type(4)));
constexpr int BM = 256, BK = 64, HALF = 128, HTB = HALF * BK * 2  , STAGE_BYTES = 8 * HTB, NXCD = 8, WGM = 8;

__host__ __device__ __forceinline__ int lds_byte(int r, int c) { const int st = (r >> 4) * 2 + (c >> 5), rr = r & 15, cc = c & 31, ob = rr * 64 + cc * 2; return st * 1024 + (ob ^ (((ob >> 9) & 1) << 5)); }
__host__ __device__ __forceinline__ void stage_rc(int b, int& R, int& C) { const int st = b / 1024, sb = b % 1024, swz = sb ^ (((sb >> 9) & 1) << 5); R = (st >> 1) * 16 + swz / 64; C = (st & 1) * 32 + (swz % 64) / 2; }
__host__ __device__ __forceinline__ int perm32(int rho) { const int n = rho >> 4, i = rho & 15; return 8 * (i >> 2) + 4 * n + (i & 3); }

struct Unit { int pm, pn; };
struct Gemm { const bf16_t* A; const bf16_t* Bt; int M, N, K; };

struct StaticOrder {
    int nM, nN, nwg, G, c, rounds;
    __host__ __device__ void init(int M, int N, int G_, int c_) { nM = M / BM; nN = N / BM; nwg = nM * nN; G = G_; c = c_; rounds = 1 << 30; }
    __host__ __device__ bool next(int i, Unit& u) const {
        const long L = (long)i * G + c; if (L >= nwg || i >= rounds) return false;
        int wgid = (int)L; { const int q = nwg / NXCD, r = nwg % NXCD, xcd = wgid % NXCD, off = wgid / NXCD; wgid = (xcd < r ? xcd * (q + 1) : r * (q + 1) + (xcd - r) * q) + off; }
        const int nig = WGM * nN, gid = wgid / nig, fm = gid * WGM, gsz = (nM - fm) < WGM ? (nM - fm) : WGM;
        u.pm = fm + ((wgid % nig) % gsz); u.pn = (wgid % nig) / gsz; return true;
    }
    __device__ __forceinline__ void a_ready(const Unit&) const {}
    __device__ __forceinline__ void done(const Unit&) const {}
};

__device__ __forceinline__ unsigned cvt_pk_bf16(float lo, float hi) { unsigned r; asm volatile("v_cvt_pk_bf16_f32 %0, %1, %2" : "=v"(r) : "v"(lo), "v"(hi)); return r; }
typedef float f32x2 __attribute__((ext_vector_type(2)));
typedef unsigned u32x2v __attribute__((ext_vector_type(2)));
constexpr int DM = 2048;
constexpr float LOG2E = 1.4426950408889634f;
__device__ __forceinline__ float fast_sigmoid(float x) { return __builtin_amdgcn_rcpf(1.0f + __builtin_amdgcn_exp2f(-x * LOG2E)); }
__device__ __forceinline__ float fast_silu(float x) { return x * fast_sigmoid(x); }
__device__ __forceinline__ float gate_sig(float x) { return fmaxf(fast_sigmoid(x), 1e-18f); }
__device__ __forceinline__ u32x4 pack8(const f32x4 a, const f32x4 b) { u32x4 w; w.x = cvt_pk_bf16(a[0], a[1]); w.y = cvt_pk_bf16(a[2], a[3]); w.z = cvt_pk_bf16(b[0], b[1]); w.w = cvt_pk_bf16(b[2], b[3]); return w; }
__device__ __forceinline__ f32x4 bf_lo4(const u32x4 w) { return (f32x4){__uint_as_float(w.x << 16), __uint_as_float(w.x & 0xffff0000u), __uint_as_float(w.y << 16), __uint_as_float(w.y & 0xffff0000u)}; }
__device__ __forceinline__ f32x4 bf_hi4(const u32x4 w) { return (f32x4){__uint_as_float(w.z << 16), __uint_as_float(w.z & 0xffff0000u), __uint_as_float(w.w << 16), __uint_as_float(w.w & 0xffff0000u)}; }
__device__ __forceinline__ float row_rstd(const float* ss, int row) {
    const f32x4 a = *(const f32x4*)(ss + (size_t)row * 8), b = *(const f32x4*)(ss + (size_t)row * 8 + 4);
    const float s = ((a[0] + a[1]) + (a[2] + a[3])) + ((b[0] + b[1]) + (b[2] + b[3]));
    return 1.0f / sqrtf(s * (1.0f / (float)DM) + 1e-6f);
}

__device__ __forceinline__ void wave_rstd(const float* ss, int rowbase, int lane, int fr, float (&rs)[2][4]) {
    const float r0 = row_rstd(ss, rowbase + lane), r1 = row_rstd(ss, rowbase + HALF + lane);
#pragma unroll
    for (int m = 0; m < 4; ++m) { rs[0][m] = __shfl(r0, m * 16 + fr); rs[1][m] = __shfl(r1, m * 16 + fr); }
}

template <bool HALFM = false>
struct EpiSwiGLU {
    static constexpr bool PERM = true, AFTER_DRAIN = false, KEEP_ACC = false;
    bf16_t* H; const float* ss; int ldh;
    __device__ __forceinline__ void operator()(const f32x4 (&acc)[2][2][4][2], const Unit& u, int wr, int wc, int fr, int fq) const {
        const int rowb = u.pm * (HALFM ? HALF : BM) + wr * 64, row0 = rowb + fr, col0 = u.pn * HALF + wc * 32 + 8 * fq;
        float rsv[2][4]; wave_rstd(ss, rowb, fq * 16 + fr, fr, rsv);
#pragma unroll
        for (int ai = 0; ai < (HALFM ? 1 : 2); ++ai)
#pragma unroll
            for (int m = 0; m < 4; ++m) {
                const int row = row0 + ai * HALF + m * 16; const float rs = rsv[ai][m];
                f32x4 h[2];
#pragma unroll
                for (int n = 0; n < 2; ++n) { const f32x4 a = acc[ai][0][m][n] * rs, b = acc[ai][1][m][n] * rs;
                    h[n] = (f32x4){fast_silu(a[0]) * b[0], fast_silu(a[1]) * b[1], fast_silu(a[2]) * b[2], fast_silu(a[3]) * b[3]}; }
                *(u32x4*)(H + (size_t)row * ldh + col0) = pack8(h[0], h[1]);
                asm volatile("" ::: "memory");
            }
    }
};

struct EpiResid {
    static constexpr bool PERM = true, AFTER_DRAIN = true, KEEP_ACC = false;
    const float* xin; float* xout; bf16_t* xb; float* ss; float coef;
    __device__ __forceinline__ void fused(f32x4 (&acc)[2][2][4][2], const Unit& u, int wr, int wc, int fr, int fq, PG8_LAS unsigned char* lds, int wid, int lane) const {
        PG8_LAS float* P = (PG8_LAS float*)lds;
        const int row0 = u.pm * BM + wr * 64 + fr, col0 = u.pn * BM + wc * 32 + 8 * fq;
#pragma unroll
        for (int ai = 0; ai < 2; ++ai) {
            f32x4 xv[4][2][2];
#pragma unroll
            for (int m = 0; m < 4; ++m)
#pragma unroll
                for (int bj = 0; bj < 2; ++bj) { const size_t off = (size_t)(row0 + ai * HALF + m * 16) * DM + col0 + bj * HALF; xv[m][bj][0] = *(const f32x4*)(xin + off); xv[m][bj][1] = *(const f32x4*)(xin + off + 4); }
            asm volatile("" ::: "memory");
#pragma unroll
            for (int m = 0; m < 4; ++m) {
                const int row = row0 + ai * HALF + m * 16; float sq = 0.f;
#pragma unroll
                for (int bj = 0; bj < 2; ++bj) { const size_t off = (size_t)row * DM + col0 + bj * HALF;
                    f32x4 v0 = xv[m][bj][0], v1 = xv[m][bj][1];
                    v0 = v0 + acc[ai][bj][m][0] * coef; v1 = v1 + acc[ai][bj][m][1] * coef;
                    *(f32x4*)(xout + off) = v0; *(f32x4*)(xout + off + 4) = v1; *(u32x4*)(xb + off) = pack8(v0, v1);
                    sq += ((v0[0] * v0[0] + v0[1] * v0[1]) + (v0[2] * v0[2] + v0[3] * v0[3])) + ((v1[0] * v1[0] + v1[1] * v1[1]) + (v1[2] * v1[2] + v1[3] * v1[3])); }
                sq += __shfl_xor(sq, 16); sq += __shfl_xor(sq, 32);
                if (fq == 0) P[(ai * HALF + wr * 64 + m * 16 + fr) * 4 + wc] = sq;
            }
            asm volatile("" ::: "memory");
        }
        asm volatile("s_waitcnt lgkmcnt(0)" ::: "memory"); __builtin_amdgcn_s_barrier(); asm volatile("" ::: "memory");
        const int t = wid * 64 + lane;
        if (t < 256) { const f32x4 p = *(const PG8_LAS f32x4*)(P + t * 4); ss[(size_t)(u.pm * BM + t) * 8 + u.pn] = (p[0] + p[1]) + (p[2] + p[3]); }
        asm volatile("s_waitcnt lgkmcnt(0)" ::: "memory"); __builtin_amdgcn_s_barrier(); asm volatile("" ::: "memory");
    }
};

struct EpiWin {
    static constexpr bool PERM = true, AFTER_DRAIN = false, KEEP_ACC = false;
    const float* ss; bf16_t *U, *FQ, *FK, *FV, *RQ, *RK, *RV, *RG, *GATES; const float *rcos, *rsin;
    __device__ __forceinline__ void operator()(const f32x4 (&acc)[2][2][4][2], const Unit& u, int wr, int wc, int fr, int fq) const {
        const int row0 = u.pm * BM + wr * 64 + fr; const int reg = u.pn >> 2;
        if (reg == 4 || reg == 5) {
            const int head = 2 * (u.pn & 3) + (wc >> 1), j0 = 32 * (wc & 1) + 8 * fq;
            const float lg = log2f(1.0f - exp2f(-5.0f - (float)head));
            bf16_t* dst = (reg == 4) ? RQ : RK;
            float rsv[2][4]; wave_rstd(ss, u.pm * BM + wr * 64, fq * 16 + fr, fr, rsv);
#pragma unroll
            for (int ai = 0; ai < 2; ++ai)
#pragma unroll
                for (int mp = 0; mp < 2; ++mp) {
                    f32x4 cs[2][2], sn[2][2];
#pragma unroll
                    for (int mm = 0; mm < 2; ++mm) { const int t = (row0 + ai * HALF + (2 * mp + mm) * 16) & 2047;
#pragma unroll
                        for (int n = 0; n < 2; ++n) { cs[mm][n] = *(const f32x4*)(rcos + t * 64 + j0 + 4 * n); sn[mm][n] = *(const f32x4*)(rsin + t * 64 + j0 + 4 * n); } }
                    asm volatile("" ::: "memory");
#pragma unroll
                    for (int mm = 0; mm < 2; ++mm) { const int m = 2 * mp + mm, row = row0 + ai * HALF + m * 16, t = row & 2047;
                        const float sc = rsv[ai][m] * ((reg == 4) ? exp2f((float)t * lg) * 0.08838834764831845f : exp2f(-(float)t * lg));
                        f32x4 o1[2], o2[2];
#pragma unroll
                        for (int n = 0; n < 2; ++n) { const f32x4 x1 = acc[ai][0][m][n] * sc, x2 = acc[ai][1][m][n] * sc; o1[n] = x1 * cs[mm][n] - x2 * sn[mm][n]; o2[n] = x1 * sn[mm][n] + x2 * cs[mm][n]; }
                        bf16_t* p = dst + (size_t)row * 1024 + head * 128 + j0;
                        *(u32x4*)p = pack8(o1[0], o1[1]); *(u32x4*)(p + 64) = pack8(o2[0], o2[1]); }
                    asm volatile("" ::: "memory");
                }
            return;
        }
        bf16_t* dst; int ldc, colt; int act = 0; float mul = 1.f;
        if (reg < 8) { ldc = 1024; colt = (u.pn & 3) * BM;
            dst = reg == 0 ? U : reg == 1 ? FQ : reg == 2 ? FK : reg == 3 ? FV : reg == 6 ? RV : RG;
            if (reg == 1) mul = 0.08838834764831845f * LOG2E;
            if (reg == 7) act = 1; }
        else { ldc = 6144; colt = (u.pn - 32) * BM; dst = GATES; act = 2; }
        const int col0 = colt + wc * 32 + 8 * fq;
        float rsv[2][4]; wave_rstd(ss, u.pm * BM + wr * 64, fq * 16 + fr, fr, rsv);
#pragma unroll
        for (int ai = 0; ai < 2; ++ai)
#pragma unroll
            for (int m = 0; m < 4; ++m) {
                const int row = row0 + ai * HALF + m * 16; const float rs = rsv[ai][m] * mul;
#pragma unroll
                for (int bj = 0; bj < 2; ++bj) { f32x4 v0 = acc[ai][bj][m][0] * rs, v1 = acc[ai][bj][m][1] * rs;
                    if (act == 1) { v0 = (f32x4){fast_silu(v0[0]), fast_silu(v0[1]), fast_silu(v0[2]), fast_silu(v0[3])}; v1 = (f32x4){fast_silu(v1[0]), fast_silu(v1[1]), fast_silu(v1[2]), fast_silu(v1[3])}; }
                    if (act == 2) { v0 = (f32x4){gate_sig(v0[0]), gate_sig(v0[1]), gate_sig(v0[2]), gate_sig(v0[3])}; v1 = (f32x4){gate_sig(v1[0]), gate_sig(v1[1]), gate_sig(v1[2]), gate_sig(v1[3])}; }
                    *(u32x4*)(dst + (size_t)row * ldc + col0 + bj * HALF) = pack8(v0, v1); }
                asm volatile("" ::: "memory");
            }
    }
};

struct EpiBranch {
    static constexpr bool PERM = true, AFTER_DRAIN = false, KEEP_ACC = true;
    const bf16_t* GATES; bf16_t* MGB;
    __device__ __forceinline__ void operator()(f32x4 (&acc)[2][2][4][2], const Unit& u, int wr, int wc, int fr, int fq) const {
        const int br = u.pm >> 5, pm = u.pm & 31, pn = u.pn & 7;
        const int row0 = pm * BM + wr * 64 + fr, col0 = pn * BM + wc * 32 + 8 * fq;
#pragma unroll
        for (int ai = 0; ai < 2; ++ai) {
            u32x4 gc[4][2], gx[4][2];
#pragma unroll
            for (int m = 0; m < 4; ++m)
#pragma unroll
                for (int bj = 0; bj < 2; ++bj) { const bf16_t* gp = GATES + (size_t)(row0 + ai * HALF + m * 16) * 6144 + br * DM + col0 + bj * HALF;
                    gc[m][bj] = *(const u32x4*)gp; gx[m][bj] = (br < 2) ? *(const u32x4*)(gp + DM) : gc[m][bj]; }
            asm volatile("" ::: "memory");
#pragma unroll
            for (int m = 0; m < 4; ++m) {
                const int row = row0 + ai * HALF + m * 16;
#pragma unroll
                for (int bj = 0; bj < 2; ++bj) {
                    const u32x4 g = gc[m][bj]; f32x4 s0 = bf_lo4(g), s1 = bf_hi4(g);
                    if (br < 2) { const u32x4 gn = gx[m][bj]; s0 = s0 / bf_lo4(gn); s1 = s1 / bf_hi4(gn);
                        acc[ai][bj][m][0] = acc[ai][bj][m][0] * s0; acc[ai][bj][m][1] = acc[ai][bj][m][1] * s1; }
                    else { *(u32x4*)(MGB + (size_t)row * DM + col0 + bj * HALF) = pack8(acc[ai][bj][m][0] * s0, acc[ai][bj][m][1] * s1);
                        acc[ai][bj][m][0] = (f32x4){0.f, 0.f, 0.f, 0.f}; acc[ai][bj][m][1] = (f32x4){0.f, 0.f, 0.f, 0.f}; } }
            }
            asm volatile("" ::: "memory");
        }
    }
};
struct HalfTailOrder {
    StaticOrder so; int half, full_rounds;
    __device__ bool next(int i, Unit& u) const { if (i > 0) return false; StaticOrder s2 = so; s2.rounds = 1 << 30; Unit t; if (!s2.next(full_rounds, t)) return false; u.pm = 2 * t.pm + half; u.pn = t.pn; return true; }
    __device__ __forceinline__ void a_ready(const Unit&) const {}
    __device__ __forceinline__ void done(const Unit&) const {}
};
struct BranchOrder {
    StaticOrder so;
    __device__ bool next(int i, Unit& u) const { if (i >= 3) return false; Unit t; if (!so.next(0, t)) return false; u.pm = i * 32 + t.pm; u.pn = i * 8 + t.pn; return true; }
    __device__ __forceinline__ void a_ready(const Unit&) const {}
    __device__ __forceinline__ void done(const Unit&) const {}
};

struct EpiFold {
    static constexpr bool PERM = true, AFTER_DRAIN = false, KEEP_ACC = false;
    bf16_t* WBR; size_t layer_stride;
    __device__ __forceinline__ void operator()(const f32x4 (&acc)[2][2][4][2], const Unit& u, int wr, int wc, int fr, int fq) const {
        const int lg = u.pn, l = lg >> 2, g = lg & 3, ob = (u.pm & 7) * BM;
        bf16_t* base = WBR + (size_t)l * layer_stride + g * 256 + wc * 32 + 8 * fq;
#pragma unroll
        for (int ai = 0; ai < 2; ++ai)
#pragma unroll
            for (int m = 0; m < 4; ++m) { const int o = ob + ai * HALF + wr * 64 + m * 16 + fr;
#pragma unroll
                for (int bj = 0; bj < 2; ++bj) *(u32x4*)(base + (size_t)o * 1024 + bj * HALF) = pack8(acc[ai][bj][m][0], acc[ai][bj][m][1]); }
    }
};
struct FoldOrder {
    int c;
    __device__ bool next(int i, Unit& u) const { if (i > 0 || c >= 128) return false; u.pm = c; u.pn = c >> 3; return true; }
    __device__ __forceinline__ void a_ready(const Unit&) const {}
    __device__ __forceinline__ void done(const Unit&) const {}
};

template <class Epi, class Sched, bool ALIGN_EPI = false, bool SP2 = false, bool HALF_M = false>
__device__ __forceinline__ void gemm_phase(PG8_LAS unsigned char* lds, const Gemm g, const Sched& S, const Epi& E) {
    int tid_ = threadIdx.x; asm volatile("" : "+v"(tid_));
    const int tid = tid_, wid = __builtin_amdgcn_readfirstlane(tid >> 6), lane = tid & 63, wr = wid >> 2, wc = wid & 3, fr = lane & 15, fq = lane >> 4;
    const int K = g.K, nt = K / BK;
    unsigned voffA[2], voffB[2];
#pragma unroll
    for (int i = 0; i < 2; ++i) { int R, C; stage_rc(tid * 16 + i * 8192, R, C); const int Rb = Epi::PERM ? ((R & ~31) + perm32(R & 31)) : R;
        voffA[i] = (unsigned)(R * K + C) * 2u; voffB[i] = (unsigned)(Rb * K + C) * 2u; }
    const size_t kstep = (size_t)(BK * 2);
    const size_t hstep = (size_t)HALF * K * 2;
    const size_t tstep = 2 * hstep;
    const unsigned ldsw = (unsigned)wid * 1024u;
    const int aoff = lds_byte(wr * 64 + fr, fq * 8), boff = lds_byte(wc * 32 + fr, fq * 8);
#define PG8_SA(b, h) (((b) * 2 + (h)) * HTB)
#define PG8_SB(b, h) ((4 + (b) * 2 + (h)) * HTB)
#define PG8_STAGE(bufoff, gbase, voff) do { _Pragma("unroll") for (int _i = 0; _i < 2; ++_i) \
        __builtin_amdgcn_global_load_lds((const unsigned*)((const char*)(gbase) + (voff)[_i]), (PG8_LAS unsigned*)(lds + (bufoff) + ldsw + _i * 8192), 16, 0, 0); } while (0)
#define PG8_LDA(dst, b, h) do { _Pragma("unroll") for (int m = 0; m < 4; ++m) _Pragma("unroll") for (int k = 0; k < 2; ++k) dst[m][k] = *(const PG8_LAS bf16x8*)(lds + PG8_SA(b, h) + aoff + m * 2048 + k * 1024); } while (0)
#define PG8_LDB(dst, b, h) do { _Pragma("unroll") for (int n = 0; n < 2; ++n) _Pragma("unroll") for (int k = 0; k < 2; ++k) dst[n][k] = *(const PG8_LAS bf16x8*)(lds + PG8_SB(b, h) + boff + n * 2048 + k * 1024); } while (0)
#define PG8_MMA(ai, bj, At, Bt) do { __builtin_amdgcn_s_setprio(1); _Pragma("unroll") for (int m = 0; m < 4; ++m) _Pragma("unroll") for (int n = 0; n < 2; ++n) _Pragma("unroll") for (int k = 0; k < 2; ++k) \
        acc[ai][bj][m][n] = __builtin_amdgcn_mfma_f32_16x16x32_bf16(Bt[n][k], At[m][k], acc[ai][bj][m][n], 0, 0, 0); __builtin_amdgcn_s_setprio(0); } while (0)
#define PG8_WAIT_V(n) asm volatile("s_waitcnt vmcnt(" #n ")" ::: "memory")
#define PG8_WAIT_L(n) asm volatile("s_waitcnt lgkmcnt(" #n ")" ::: "memory")
#define PG8_BAR __builtin_amdgcn_s_barrier()
#define PG8_SCHED __builtin_amdgcn_sched_barrier(0)
    Unit cur, nxt; int ui = 0;
    if (!S.next(0, cur)) return;
    f32x4 acc[2][2][4][2];
#pragma unroll
    for (int a = 0; a < 2; ++a)
#pragma unroll
        for (int b = 0; b < 2; ++b)
#pragma unroll
            for (int m = 0; m < 4; ++m)
#pragma unroll
                for (int n = 0; n < 2; ++n) acc[a][b][m][n] = (f32x4){0.f, 0.f, 0.f, 0.f};
    bf16x8 At[4][2], B0[2][2], B1[2][2];
    const size_t mstep = HALF_M ? hstep : tstep;
    const char* cA = (const char*)g.A + (size_t)cur.pm * mstep; const char* cB = (const char*)g.Bt + (size_t)cur.pn * tstep;
    S.a_ready(cur);
    if constexpr (SP2) {
        PG8_STAGE(PG8_SB(0, 0), cB, voffB); PG8_STAGE(PG8_SB(0, 1), cB + hstep, voffB); PG8_STAGE(PG8_SA(0, 0), cA, voffA); if constexpr (!HALF_M) PG8_STAGE(PG8_SA(0, 1), cA + hstep, voffA);
        if (wr == 1) PG8_BAR;
        if constexpr (HALF_M) PG8_WAIT_V(0); else PG8_WAIT_V(2);
        PG8_BAR;
        PG8_STAGE(PG8_SB(1, 0), cB + kstep, voffB); PG8_STAGE(PG8_SA(1, 0), cA + kstep, voffA); PG8_STAGE(PG8_SB(1, 1), cB + hstep + kstep, voffB);
        PG8_WAIT_V(6); PG8_BAR;
    } else {
        PG8_STAGE(PG8_SB(0, 0), cB, voffB); PG8_STAGE(PG8_SA(0, 0), cA, voffA); PG8_STAGE(PG8_SB(0, 1), cB + hstep, voffB); PG8_STAGE(PG8_SA(0, 1), cA + hstep, voffA);
        if (wr == 1) PG8_BAR;
        PG8_WAIT_V(4); PG8_BAR;
        PG8_STAGE(PG8_SB(1, 0), cB + kstep, voffB); PG8_STAGE(PG8_SA(1, 0), cA + kstep, voffA); PG8_STAGE(PG8_SB(1, 1), cB + hstep + kstep, voffB);
        PG8_WAIT_V(6); PG8_BAR;
    }
    for (;;) {
        const bool has_next = S.next(ui + 1, nxt);
        const char* nA = has_next ? (const char*)g.A + (size_t)nxt.pm * mstep : cA; const char* nB = has_next ? (const char*)g.Bt + (size_t)nxt.pn * tstep : cB;
        for (int t = 0; t < nt; t += 2) {
            const bool last = (t == nt - 2);
            const char* a1 = cA + (size_t)(t + 1) * kstep;
            const char* a2 = last ? nA : cA + (size_t)(t + 2) * kstep; const char* b2 = last ? nB : cB + (size_t)(t + 2) * kstep;
            const char* a3 = a2 + kstep; const char* b3 = b2 + kstep;
            if (last && has_next) S.a_ready(nxt);
            if constexpr (SP2) {
            if constexpr (!HALF_M) {
            PG8_LDB(B0, 0, 0); PG8_LDB(B1, 0, 1); PG8_SCHED; PG8_LDA(At, 0, 0); PG8_STAGE(PG8_SA(1, 1), a1 + hstep, voffA);
            PG8_WAIT_V(8); PG8_WAIT_L(0); PG8_BAR; PG8_MMA(0, 0, At, B0); PG8_MMA(0, 1, At, B1); PG8_BAR; PG8_SCHED;
            PG8_LDA(At, 0, 1); PG8_STAGE(PG8_SB(0, 0), b2, voffB); PG8_STAGE(PG8_SB(0, 1), b2 + hstep, voffB); PG8_STAGE(PG8_SA(0, 0), a2, voffA);
            PG8_WAIT_V(8); PG8_WAIT_L(0); PG8_BAR; PG8_MMA(1, 0, At, B0); PG8_MMA(1, 1, At, B1); PG8_BAR; PG8_SCHED;
            PG8_LDB(B0, 1, 0); PG8_LDB(B1, 1, 1); PG8_SCHED; PG8_LDA(At, 1, 0); PG8_STAGE(PG8_SA(0, 1), a2 + hstep, voffA);
            PG8_WAIT_V(8); PG8_WAIT_L(0); PG8_BAR; PG8_MMA(0, 0, At, B0); PG8_MMA(0, 1, At, B1); PG8_BAR; PG8_SCHED;
            PG8_LDA(At, 1, 1); PG8_STAGE(PG8_SB(1, 0), b3, voffB); PG8_STAGE(PG8_SB(1, 1), b3 + hstep, voffB); PG8_STAGE(PG8_SA(1, 0), a3, voffA);
            PG8_WAIT_V(8); PG8_WAIT_L(0); PG8_BAR; PG8_MMA(1, 0, At, B0); PG8_MMA(1, 1, At, B1); PG8_BAR; PG8_SCHED;
            } else {
            (void)a1;
            PG8_LDB(B0, 0, 0); PG8_LDB(B1, 0, 1); PG8_SCHED; PG8_LDA(At, 0, 0);
            PG8_WAIT_L(0); PG8_BAR; PG8_MMA(0, 0, At, B0); PG8_MMA(0, 1, At, B1); PG8_BAR; PG8_SCHED;
            PG8_STAGE(PG8_SB(0, 0), b2, voffB); PG8_STAGE(PG8_SB(0, 1), b2 + hstep, voffB); PG8_STAGE(PG8_SA(0, 0), a2, voffA);
            PG8_WAIT_V(6); PG8_BAR; PG8_BAR; PG8_SCHED;
            PG8_LDB(B0, 1, 0); PG8_LDB(B1, 1, 1); PG8_SCHED; PG8_LDA(At, 1, 0);
            PG8_WAIT_L(0); PG8_BAR; PG8_MMA(0, 0, At, B0); PG8_MMA(0, 1, At, B1); PG8_BAR; PG8_SCHED;
            PG8_STAGE(PG8_SB(1, 0), b3, voffB); PG8_STAGE(PG8_SB(1, 1), b3 + hstep, voffB); PG8_STAGE(PG8_SA(1, 0), a3, voffA);
            PG8_WAIT_V(6); PG8_BAR; PG8_BAR; PG8_SCHED;
            }
            } else {
            PG8_LDB(B0, 0, 0); PG8_SCHED; PG8_LDA(At, 0, 0); PG8_STAGE(PG8_SA(1, 1), a1 + hstep, voffA);
            PG8_WAIT_L(8); PG8_BAR; PG8_WAIT_L(0); PG8_MMA(0, 0, At, B0); PG8_BAR; PG8_SCHED;
            PG8_LDB(B1, 0, 1); PG8_STAGE(PG8_SB(0, 0), b2, voffB);
            PG8_BAR; PG8_WAIT_L(0); PG8_MMA(0, 1, At, B1); PG8_BAR;
            PG8_LDA(At, 0, 1); PG8_STAGE(PG8_SA(0, 0), a2, voffA);
            PG8_BAR; PG8_WAIT_L(0); PG8_MMA(1, 0, At, B0); PG8_BAR; PG8_SCHED;
            PG8_STAGE(PG8_SB(0, 1), b2 + hstep, voffB);
            PG8_WAIT_V(6); PG8_BAR; PG8_MMA(1, 1, At, B1); PG8_BAR;
            PG8_LDB(B0, 1, 0); PG8_SCHED; PG8_LDA(At, 1, 0); PG8_STAGE(PG8_SA(0, 1), a2 + hstep, voffA);
            PG8_WAIT_L(8); PG8_BAR; PG8_WAIT_L(0); PG8_MMA(0, 0, At, B0); PG8_BAR; PG8_SCHED;
            PG8_LDB(B1, 1, 1); PG8_STAGE(PG8_SB(1, 0), b3, voffB);
            PG8_BAR; PG8_WAIT_L(0); PG8_MMA(0, 1, At, B1); PG8_BAR;
            PG8_LDA(At, 1, 1); PG8_STAGE(PG8_SA(1, 0), a3, voffA);
            PG8_BAR; PG8_WAIT_L(0); PG8_MMA(1, 0, At, B0); PG8_BAR; PG8_SCHED;
            PG8_STAGE(PG8_SB(1, 1), b3 + hstep, voffB);
            PG8_WAIT_V(6); PG8_BAR; PG8_MMA(1, 1, At, B1); PG8_BAR;
            }
        }
        if constexpr (ALIGN_EPI) { if (wr == 0) PG8_BAR; }
        if constexpr (!Epi::AFTER_DRAIN) { E(acc, cur, wr, wc, fr, fq); S.done(cur); }
        if (!has_next) break;
        if constexpr (!Epi::KEEP_ACC) {
#pragma unroll
        for (int a = 0; a < 2; ++a)
#pragma unroll
            for (int b = 0; b < 2; ++b)
#pragma unroll
                for (int m = 0; m < 4; ++m)
#pragma unroll
                    for (int n = 0; n < 2; ++n) acc[a][b][m][n] = (f32x4){0.f, 0.f, 0.f, 0.f};
        }
        cur = nxt; cA = nA; cB = nB; ++ui;
        if constexpr (ALIGN_EPI) { if (wr == 1) PG8_BAR; }
    }
    PG8_WAIT_V(0);
    if constexpr (!ALIGN_EPI) { if (wr == 0) PG8_BAR; }
    PG8_BAR;
    if constexpr (Epi::AFTER_DRAIN) { E.fused(acc, cur, wr, wc, fr, fq, lds, wid, lane); S.done(cur); }
#undef PG8_SA
#undef PG8_SB
#undef PG8_STAGE
#undef PG8_LDA
#undef PG8_LDB
#undef PG8_MMA
#undef PG8_WAIT_V
#undef PG8_WAIT_L
#undef PG8_BAR
#undef PG8_SCHED
}
}

constexpr int NWAVES = 8;
constexpr int BATCH = 4, SEQ = 2048, D = 2048, DEPTH = 4, M = BATCH * SEQ;
constexpr int DFF = 5632, NH = 8, HD = 128, WIDE = 1024;
constexpr int IN_W = 14344, WIN_N = 14336;
constexpr int SRC_FQ = 1024, SRC_FLOGIT = 4096, SRC_RQ = 4104, SRC_RK = 5128, SRC_RV = 6152, SRC_RG = 7176, SRC_GATES = 8200;
#ifndef MK_PER_PHASE
#define MK_PER_PHASE 0
#endif
constexpr int N_PHASES = 2 + 8 * 2 + 4 * 4 + 1;

constexpr size_t MiB = 1u << 20;
constexpr size_t WS_CTL = 0, CTL_ZERO_BYTES = 1 * MiB;
constexpr size_t WS_WF = 1 * MiB;
constexpr size_t WS_COS = 2 * MiB, WS_SIN = 2 * MiB + 512 * 1024;
constexpr size_t WS_SS = 3 * MiB;
constexpr size_t WS_FL = 3 * MiB + 512 * 1024;
constexpr size_t WS_WP = 4 * MiB;
constexpr size_t WS_WBPT = 6 * MiB;
constexpr size_t WS_W13T = 32 * MiB,  SZ_W13T = (size_t)2 * DFF * D * 2;
constexpr size_t WS_W2T = WS_W13T + 8 * SZ_W13T, SZ_W2T = (size_t)D * DFF * 2;
constexpr size_t WS_WINT = WS_W2T + 8 * SZ_W2T, SZ_WINT = (size_t)WIN_N * D * 2;
constexpr size_t WS_WBR = WS_WINT + 4 * SZ_WINT, SZ_WBR = (size_t)3 * D * WIDE * 2;
constexpr size_t WS_WOUT = WS_WBR + 4 * SZ_WBR, SZ_WOUT = (size_t)D * D * 2;
constexpr size_t WS_X = WS_WOUT + 4 * SZ_WOUT;
constexpr size_t WS_XB = WS_X + (size_t)M * D * 4;
constexpr size_t WS_H = WS_XB + (size_t)M * D * 2;
constexpr size_t SZ_ACT = (size_t)M * WIDE * 2;
constexpr size_t WS_U = WS_H + (size_t)M * DFF * 2;
constexpr size_t WS_FQ = WS_U + SZ_ACT, WS_FK = WS_FQ + SZ_ACT, WS_FV = WS_FK + SZ_ACT, WS_RQ = WS_FV + SZ_ACT, WS_RK = WS_RQ + SZ_ACT, WS_RV = WS_RK + SZ_ACT, WS_RG = WS_RV + SZ_ACT;
constexpr size_t WS_GATES = WS_RG + SZ_ACT;
constexpr size_t WS_BRA = WS_GATES + (size_t)M * 6144 * 2;
constexpr size_t WS_MG = WS_BRA + 3 * SZ_ACT;
constexpr size_t WS_MGB = WS_MG + (size_t)M * D * 4;
constexpr size_t WS_END = WS_MGB + (size_t)M * D * 2;
static_assert(WS_W13T % 256 == 0 && SZ_W13T % 256 == 0 && SZ_W2T % 256 == 0 && SZ_WINT % 256 == 0 && WS_X % 256 == 0 && WS_END < (size_t)1700 * MiB, "d_ws map");
constexpr int CW_TMO = 0, CW_CODE = 1;
constexpr int CW_QUEUE = 64;
constexpr int CW_BAR = 4096;
constexpr int RING_OFF = 0, RING_BYTES = 131072;
constexpr int LDSCTL_OFF = RING_BYTES, MISC_OFF = LDSCTL_OFF + 320;
constexpr int LDS_BYTES = 147456;
static_assert(MISC_OFF + 128 <= LDS_BYTES, "LDS map");

#define GAS __attribute__((address_space(1)))
#define LAS __attribute__((address_space(3)))
typedef unsigned short bf16;
typedef unsigned v4u __attribute__((ext_vector_type(4)));
typedef unsigned v2u __attribute__((ext_vector_type(2)));
typedef float f32x4 __attribute__((ext_vector_type(4)));
typedef float f32x16 __attribute__((ext_vector_type(16)));
typedef short bf16x8 __attribute__((ext_vector_type(8)));
typedef short s16x4 __attribute__((ext_vector_type(4)));
typedef GAS unsigned gu32;
#define RLX_AGENT __ATOMIC_RELAXED, __HIP_MEMORY_SCOPE_AGENT
#define LDS_WAIT() asm volatile("s_waitcnt lgkmcnt(0)" ::: "memory")
#define VM_WAIT() asm volatile("s_waitcnt vmcnt(0)" ::: "memory")
__device__ __forceinline__ unsigned f2bf(float f) { unsigned u = __builtin_bit_cast(unsigned, f); return (u + 0x7fffu + ((u >> 16) & 1u)) >> 16; }
__device__ __forceinline__ unsigned pk2(float lo, float hi) { return f2bf(lo) | (f2bf(hi) << 16); }
__device__ __forceinline__ float bf2f(unsigned short h) { return __uint_as_float((unsigned)h << 16); }

#define XB_TMO      128
#define XB_XCNT(j)  (256  + 64 * (j))
#define XB_XSUB(j)  (1280 + 64 * (j))
#define XB_XGEN(j)  (2304 + 64 * (j))
#define XB_TOP      3328
#define XB_TOPGEN   3392
#define XCD_BAR_WORDS 3456
#define XB_SPIN_CAP (1u << 18)

__device__ __forceinline__ unsigned xb_ld(unsigned* p)              { return __hip_atomic_load(p, __ATOMIC_RELAXED, __HIP_MEMORY_SCOPE_AGENT); }
__device__ __forceinline__ unsigned xb_add(unsigned* p, unsigned v) { return __hip_atomic_fetch_add(p, v, __ATOMIC_RELAXED, __HIP_MEMORY_SCOPE_AGENT); }
__device__ __forceinline__ unsigned xb_xcc_id() { return (unsigned)__builtin_amdgcn_s_getreg((3 << 11) | 20) & 0xFu; }
#define XB_SPIN(cond, bar) do { unsigned _sp = 0; while (cond) { __builtin_amdgcn_s_sleep(1); \
    if ((++_sp & 255u) == 0u) { if (xb_ld(&(bar)[XB_TMO])) break; if (_sp > XB_SPIN_CAP) { atomicAdd(&(bar)[XB_TMO], 1u); break; } } } } while (0)

struct XcdBarrier {
    unsigned* bar; unsigned x;
    volatile LAS unsigned* st;
};

__device__ __forceinline__ XcdBarrier xcd_barrier_post(unsigned* bar, volatile LAS unsigned* st) {
    XcdBarrier b; b.bar = bar; b.x = xb_xcc_id(); b.st = st;
    if (threadIdx.x == 0) (void)xb_add(&bar[XB_XCNT(b.x)], 1u);
    return b;
}
__device__ __forceinline__ void xcd_barrier_complete(unsigned* bar, unsigned x, unsigned& nloc, unsigned& nx) {
    const unsigned G = gridDim.x * gridDim.y * gridDim.z;
    unsigned sum, cnt, mine, sp = 0u;
    for (;;) {
        sum = 0u; cnt = 0u; mine = 0u;
#pragma unroll
        for (unsigned j = 0; j < 16; ++j) { const unsigned c = xb_ld(&bar[XB_XCNT(j)]); sum += c; cnt += (c > 0u) ? 1u : 0u; mine = (j == x) ? c : mine; }
        if (sum == G) break;
        __builtin_amdgcn_s_sleep(1);
        if ((++sp & 255u) == 0u) { if (xb_ld(&bar[XB_TMO])) break; if (sp > XB_SPIN_CAP) { atomicAdd(&bar[XB_TMO], 1u); break; } }
    }
    nloc = mine > 0u ? mine : 1u; nx = cnt > 0u ? cnt : 1u;
}

__device__ __forceinline__ void xcd_barrier(const XcdBarrier& b) {
    asm volatile("s_waitcnt vmcnt(0)" ::: "memory");
    __syncthreads();
    if (threadIdx.x == 0) {
        unsigned* bar = b.bar;
        __builtin_amdgcn_s_waitcnt(0);
        unsigned nloc = b.st[0], nx = b.st[1];
        if (nloc == 0u) { xcd_barrier_complete(bar, b.x, nloc, nx); b.st[0] = nloc; b.st[1] = nx; }
        const unsigned old = xb_add(&bar[XB_XSUB(b.x)], 1u);
        const unsigned gen = old / nloc;
        if (old + 1u == (gen + 1u) * nloc) {
            __builtin_amdgcn_fence(__ATOMIC_RELEASE, "agent");
            asm volatile("s_waitcnt vmcnt(0)" ::: "memory");
            const unsigned og = xb_add(&bar[XB_TOP], 1u);
            const unsigned tg = og / nx;
            if (og + 1u == (tg + 1u) * nx) xb_add(&bar[XB_TOPGEN], 1u);
            else XB_SPIN(xb_ld(&bar[XB_TOPGEN]) == tg, bar);
            __builtin_amdgcn_fence(__ATOMIC_ACQUIRE, "agent");
            xb_add(&bar[XB_XGEN(b.x)], 1u);
            asm volatile("s_waitcnt vmcnt(0)" ::: "memory");
        } else {
            XB_SPIN(xb_ld(&bar[XB_XGEN(b.x)]) == gen, bar);
            __builtin_amdgcn_fence(__ATOMIC_ACQUIRE, "agent");
            asm volatile("s_waitcnt vmcnt(0)" ::: "memory");
        }
    }
    __syncthreads();
}

struct Args {
    const float* in[17];
    float* out; unsigned char* ws;
    int ph_lo, ph_hi, li, pad;
};
enum { I_X = 0, I_F1N, I_F1W13, I_F1W2, I_MIXN, I_WIN, I_FB, I_POOLW, I_POOLS, I_WBP, I_WBF, I_WBRT, I_WOUT, I_F2N, I_F2W13, I_F2W2, I_FINN };

__device__ __forceinline__ float wave_sum(float v) {
#pragma unroll
    for (int o = 1; o < 64; o <<= 1) v += __shfl_xor(v, o);
    return v;
}

struct TrItem { const float* p; const float* gain; bf16* dst0; size_t ldsrc, ldd; };
__device__ __forceinline__ void tr_load(const TrItem& t, float (&va)[32], float (&vb)[32], float& gv, int lane) {
#pragma unroll
    for (int i = 0; i < 32; ++i) { va[i] = t.p[(size_t)(2 * i) * t.ldsrc]; vb[i] = t.p[(size_t)(2 * i) * t.ldsrc + 32]; }
    gv = t.gain ? t.gain[lane] : 1.0f;
}
__device__ __forceinline__ void tr_store(const TrItem& t, const float (&va)[32], const float (&vb)[32], float gv, LAS float* scr, int lane) {
    const int c = lane & 7;
#pragma unroll
    for (int hh = 0; hh < 2; ++hh) {
#pragma unroll
        for (int i = 0; i < 32; ++i) { const float g0 = __builtin_bit_cast(float, __builtin_amdgcn_readlane(__builtin_bit_cast(int, gv), 2 * i)), g1 = __builtin_bit_cast(float, __builtin_amdgcn_readlane(__builtin_bit_cast(int, gv), 2 * i + 1));
            scr[(2 * i + (lane >> 5)) * 33 + (lane & 31)] = (hh ? vb[i] : va[i]) * ((lane >> 5) ? g1 : g0); }
        LDS_WAIT(); asm volatile("" ::: "memory");
#pragma unroll
        for (int j = 0; j < 4; ++j) { const int n = (lane >> 3) + 8 * j; const LAS float* s = scr + (8 * c) * 33 + n;
            v4u o; o.x = pg8::cvt_pk_bf16(s[0 * 33], s[1 * 33]); o.y = pg8::cvt_pk_bf16(s[2 * 33], s[3 * 33]); o.z = pg8::cvt_pk_bf16(s[4 * 33], s[5 * 33]); o.w = pg8::cvt_pk_bf16(s[6 * 33], s[7 * 33]);
            *(GAS v4u*)(t.dst0 + (size_t)(32 * hh + n) * t.ldd + 8 * c) = o; }
        LDS_WAIT(); asm volatile("" ::: "memory");
    }
}
__device__ __forceinline__ int win_src_col(int d0) {
    const int reg = d0 >> 10, w = d0 & 1023;
    if (reg < 4) return d0;
    if (reg == 4 || reg == 5) { const int pu = w >> 8, c = w & 255, head = 2 * pu + ((c & 127) >> 6), d = (c >> 7) * 64 + (c & 63); return (reg == 4 ? SRC_RQ : SRC_RK) + head * 128 + d; }
    if (reg == 6) return SRC_RV + w;
    if (reg == 7) return SRC_RG + w;
    return SRC_GATES + (d0 - 8192);
}
__device__ __forceinline__ void sincos_red(float a, float& sn, float& cs) {
    const double x = (double)a; const double q = __builtin_rint(x * 0.6366197723675814); const int n = (int)q;
    const float r = (float)(x - q * 1.5707963267948966), r2 = r * r;
    const float s = r + r * r2 * (-1.6666654611e-1f + r2 * (8.3321608736e-3f + r2 * (-1.9515295891e-4f)));
    const float c = 1.0f - 0.5f * r2 + r2 * r2 * (4.166664568298827e-2f + r2 * (-1.388731625493765e-3f + r2 * 2.443315711809948e-5f));
    switch (n & 3) { case 0: sn = s; cs = c; break; case 1: sn = c; cs = -s; break; case 2: sn = -s; cs = -c; break; default: sn = -c; cs = s; break; }
}


__device__ __forceinline__ void p0_prologue(const Args& args, LAS unsigned char* lds, int wave, int lane, int tid, int G) {
    unsigned char* ws = args.ws;
    LAS float* scr = (LAS float*)(lds + RING_OFF + wave * 16384);
    const int gw = (int)blockIdx.x * NWAVES + wave, NGW = G * NWAVES;
    constexpr int I_W13 = 32 * 176, I_W2 = 88 * 32, I_IN = 32 * 224, I_BR = 16 * 32, I_OUT = 32 * 32;
    constexpr int I_LAYER = 2 * I_W13 + 2 * I_W2 + I_IN + 3 * I_BR + I_OUT, I_ALL = DEPTH * I_LAYER;
#define TR_DECODE(it, T) do { \
        const int itr_ = I_ALL - 1 - (it); const int l = itr_ / I_LAYER; int r = itr_ % I_LAYER;     \
        const float* src; size_t ldsrc; int k0, s0; const float* gain = nullptr; bf16* dst0; size_t ldd; \
        if (r < 2 * I_W13) { \
            const int f = r / I_W13; r %= I_W13; const int kb = r / 176, db = r % 176, d0 = 64 * db, pn = d0 >> 8, w = d0 & 255; \
            src = (f ? args.in[I_F2W13] : args.in[I_F1W13]) + (size_t)l * D * 2 * DFF; ldsrc = 2 * DFF; k0 = 64 * kb; s0 = (w >> 7) * DFF + pn * 128 + (w & 127); \
            gain = (f ? args.in[I_F2N] : args.in[I_F1N]) + l * D; dst0 = (bf16*)(ws + WS_W13T + (size_t)(2 * l + f) * SZ_W13T) + (size_t)d0 * D + k0; ldd = D; \
        } else if ((r -= 2 * I_W13) < 2 * I_W2) { \
            const int f = r / I_W2; r %= I_W2; const int kb = r / 32, db = r % 32; \
            src = (f ? args.in[I_F2W2] : args.in[I_F1W2]) + (size_t)l * DFF * D; ldsrc = D; k0 = 64 * kb; s0 = 64 * db; \
            dst0 = (bf16*)(ws + WS_W2T + (size_t)(2 * l + f) * SZ_W2T) + (size_t)s0 * DFF + k0; ldd = DFF; \
        } else if ((r -= 2 * I_W2) < I_IN) { \
            const int kb = r / 224, db = r % 224, d0 = 64 * db; \
            src = args.in[I_WIN] + (size_t)l * D * IN_W; ldsrc = IN_W; k0 = 64 * kb; s0 = win_src_col(d0); gain = args.in[I_MIXN] + l * D; \
            dst0 = (bf16*)(ws + WS_WINT + (size_t)l * SZ_WINT) + (size_t)d0 * D + k0; ldd = D; \
        } else if ((r -= I_IN) < 3 * I_BR) { \
            const int br = r / I_BR; r %= I_BR; const int kb = r / 32, db = r % 32; k0 = 64 * kb; s0 = 64 * db; ldsrc = D; \
            src = (br == 0 ? args.in[I_WBP] : br == 1 ? args.in[I_WBF] : args.in[I_WBRT]) + (size_t)l * WIDE * D; \
            if (br == 0) { gain = args.in[I_POOLS] + l * WIDE; \
                dst0 = (bf16*)(ws + WS_WBPT) + ((size_t)(l * 4 + (k0 >> 8)) * D + s0) * 256 + (k0 & 255); ldd = 256; } \
            else { dst0 = (bf16*)(ws + WS_WBR + (size_t)l * SZ_WBR) + (size_t)br * D * WIDE + (size_t)s0 * WIDE + k0; ldd = WIDE; } \
        } else { r -= 3 * I_BR; \
            const int kb = r / 32, db = r % 32; k0 = 64 * kb; s0 = 64 * db; ldsrc = D; \
            src = args.in[I_WOUT] + (size_t)l * D * D; dst0 = (bf16*)(ws + WS_WOUT + (size_t)l * SZ_WOUT) + (size_t)s0 * D + k0; ldd = D; \
        } \
        (T).p = src + (size_t)(k0 + (lane >> 5)) * ldsrc + s0 + (lane & 31); (T).gain = gain ? gain + k0 : nullptr; (T).dst0 = dst0; (T).ldsrc = ldsrc; (T).ldd = ldd; } while (0)
    {
        float vaA[32], vbA[32], vaB[32], vbB[32]; float gvA = 1.f, gvB = 1.f; TrItem tA, tB;
        int it = gw;
        if (it < I_ALL) { TR_DECODE(it, tA); tr_load(tA, vaA, vbA, gvA, lane); }
        for (; it < I_ALL; it += 2 * NGW) {
            const bool hasB = it + NGW < I_ALL, hasA2 = it + 2 * NGW < I_ALL;
            if (hasB) { TR_DECODE(it + NGW, tB); tr_load(tB, vaB, vbB, gvB, lane); }
            tr_store(tA, vaA, vbA, gvA, scr, lane);
            if (hasA2) { TR_DECODE(it + 2 * NGW, tA); tr_load(tA, vaA, vbA, gvA, lane); }
            if (hasB) tr_store(tB, vaB, vbB, gvB, scr, lane);
        }
    }
#undef TR_DECODE
    for (int m = gw; m < M; m += NGW) {
        const GAS f32x4* xr = (const GAS f32x4*)(args.in[I_X] + (size_t)m * D) + lane;
        GAS v2u* o8 = (GAS v2u*)((bf16*)(ws + WS_XB) + (size_t)m * D) + lane; float s = 0.f;
#pragma unroll
        for (int j = 0; j < 8; ++j) { const f32x4 v = xr[64 * j]; s += (v.x * v.x + v.y * v.y) + (v.z * v.z + v.w * v.w); v2u w; w.x = pk2(v.x, v.y); w.y = pk2(v.z, v.w); o8[64 * j] = w; }
        s = wave_sum(s);
        if (lane < 8) ((float*)(ws + WS_SS))[(size_t)m * 8 + lane] = lane == 0 ? s : 0.f;
    }
    const int gt = (int)blockIdx.x * (NWAVES * 64) + tid, NGT = G * NWAVES * 64;
    for (int i = gt; i < SEQ * 64; i += NGT) {
        const int t = i >> 6, j = i & 63; const float inv = powf(10000.0f, -(float)j / 64.0f); float sn, cs; sincos_red((float)t * inv, sn, cs);
        ((float*)(ws + WS_COS))[i] = cs; ((float*)(ws + WS_SIN))[i] = sn; }
    for (int i = gt; i < DEPTH * 4 * 256 * 256; i += NGT) ((bf16*)(ws + WS_WP))[i] = (bf16)f2bf(args.in[I_POOLW][i]);
    for (int i = gt; i < DEPTH * 8 * D; i += NGT) {
        const int l = i / (8 * D), h = (i / D) & 7, k = i % D;
        ((float*)(ws + WS_WF))[i] = args.in[I_WIN][(size_t)l * D * IN_W + (size_t)k * IN_W + SRC_FLOGIT + h] * args.in[I_MIXN][l * D + k]; }
}

__device__ __forceinline__ void flogit_rows(unsigned char* ws, int l, int wave, int lane) {
    const float* X = (const float*)(ws + WS_X); const float* WF = (const float*)(ws + WS_WF) + (size_t)l * 8 * D; const float* ss = (const float*)(ws + WS_SS); float* FL = (float*)(ws + WS_FL);
    const int row0 = (int)blockIdx.x * 32 + wave * 4;
    float acc[4][8];
#pragma unroll
    for (int r = 0; r < 4; ++r)
#pragma unroll
        for (int h = 0; h < 8; ++h) acc[r][h] = 0.f;
#pragma unroll 2
    for (int j = 0; j < 8; ++j) {
        f32x4 wv[8], xv[4];
#pragma unroll
        for (int h = 0; h < 8; ++h) wv[h] = *(const f32x4*)(WF + h * D + 256 * j + 4 * lane);
#pragma unroll
        for (int r = 0; r < 4; ++r) xv[r] = *(const f32x4*)(X + (size_t)(row0 + r) * D + 256 * j + 4 * lane);
#pragma unroll
        for (int r = 0; r < 4; ++r)
#pragma unroll
            for (int h = 0; h < 8; ++h) acc[r][h] += (xv[r].x * wv[h].x + xv[r].y * wv[h].y) + (xv[r].z * wv[h].z + xv[r].w * wv[h].w);
    }
#pragma unroll
    for (int r = 0; r < 4; ++r) { const float rs = pg8::row_rstd(ss, row0 + r);
#pragma unroll
        for (int h = 0; h < 8; ++h) { const float s = wave_sum(acc[r][h]); if (lane == h) FL[(size_t)(row0 + r) * 8 + h] = s * rs; } }
}

__device__ __forceinline__ unsigned off_a(unsigned row, unsigned ch) { return 2048u * (row >> 3) + 512u * (ch >> 2) + 64u * (row & 7u) + 16u * ((ch & 3u) ^ ((row >> 2) & 3u)); }
typedef short v4i16_t __attribute__((ext_vector_type(4)));
__device__ __forceinline__ s16x4 vtr(const LAS unsigned char* p) { return __builtin_bit_cast(s16x4, __builtin_amdgcn_ds_read_tr16_b64_v4i16((LAS v4i16_t*)p)); }
__device__ __forceinline__ int crow(int r, int hi) { return (r & 3) + 8 * (r >> 2) + 4 * hi; }
constexpr int AT_HALF = 65536, AT_K0 = 0, AT_V0 = 32768;
constexpr int AT_NLB = LDSCTL_OFF + 1024, AT_WTOT = AT_NLB + 8192;
static_assert(AT_WTOT + 64 <= LDS_BYTES, "mixer LDS map");
constexpr float LOG2E_F = 1.4426950408889634f;

__device__ __forceinline__ void mix_nlb(unsigned char* ws, const float* fbias_l, LAS unsigned char* lds, int b, int h, int wave, int lane, int tid) {
    LAS float* nlb = (LAS float*)(lds + AT_NLB);
    __syncthreads();
    {
        const float* FL = (const float*)(ws + WS_FL) + (size_t)b * SEQ * 8 + h; const float fb = fbias_l[h];
        float v[4]; float s = 0.f;
#pragma unroll
        for (int e = 0; e < 4; ++e) { const float z = FL[(size_t)(4 * tid + e) * 8] + fb; v[e] = (fminf(z, 0.f) - log1pf(expf(-fabsf(z)))) * LOG2E_F; s += v[e]; }
        float sc = s;
#pragma unroll
        for (int o = 1; o < 64; o <<= 1) { const float t = __shfl_up(sc, o); if (lane >= o) sc += t; }
        LAS float* wtot = (LAS float*)(lds + AT_WTOT);
        if (lane == 63) wtot[wave] = sc;
        __syncthreads();
        float pre = 0.f;
        for (int w = 0; w < wave; ++w) pre += wtot[w];
        float run = pre + (sc - s);
#pragma unroll
        for (int e = 0; e < 4; ++e) { run += v[e]; nlb[4 * tid + e] = -run; }
    }
}
template <int MODE>
__device__ __forceinline__ void mix_half(unsigned char* ws, LAS unsigned char* lds_all, int b, int h, int qb, int wave, int lane) {
    LAS unsigned char* lds = lds_all + MODE * AT_HALF;
    const LAS float* nlb = (const LAS float*)(lds_all + AT_NLB);
    const int q = lane & 31, hi = lane >> 5;
    const int R0 = 128 * qb + 32 * wave, tq = R0 + q;
    const size_t rowbase = (size_t)b * SEQ;
    const bf16* Qg = (const bf16*)(ws + (MODE ? WS_RQ : WS_FQ)) + (rowbase + tq) * WIDE + h * HD;
    const bf16* Kg = (const bf16*)(ws + (MODE ? WS_RK : WS_FK)) + rowbase * WIDE + h * HD;
    const bf16* Vg = (const bf16*)(ws + (MODE ? WS_RV : WS_FV)) + rowbase * WIDE + h * HD;
    const int nt = 2 * (qb + 1);
    bf16x8 qf[8];
#pragma unroll
    for (int s = 0; s < 8; ++s) qf[s] = *(const bf16x8*)(Qg + 16 * s + 8 * hi);
    f32x16 o[4];
#pragma unroll
    for (int c = 0; c < 4; ++c)
#pragma unroll
        for (int r = 0; r < 16; ++r) o[c][r] = 0.f;
    float mrun = -1e30f, lrun = 0.f;
    unsigned stoff0;
    { const unsigned p = (unsigned)(wave * 64 + lane), row = ((p >> 7) << 3) | ((p >> 2) & 7u), ch = (((p >> 5) & 3u) << 2) | ((p & 3u) ^ ((row >> 2) & 3u)); stoff0 = row * WIDE + ch * 8u; }
#define AT_STAGE(jt, buf) do { _Pragma("unroll") for (int _i = 0; _i < 4; ++_i) { \
        __builtin_amdgcn_global_load_lds((const unsigned*)(Kg + (size_t)(64 * (jt) + 16 * _i) * WIDE + stoff0), (LAS unsigned*)(lds + AT_K0 + (buf) * 16384 + (4 * _i + wave) * 1024), 16, 0, 0); \
        __builtin_amdgcn_global_load_lds((const unsigned*)(Vg + (size_t)(64 * (jt) + 16 * _i) * WIDE + stoff0), (LAS unsigned*)(lds + AT_V0 + (buf) * 16384 + (4 * _i + wave) * 1024), 16, 0, 0); } } while (0)
    AT_STAGE(nt - 1, 0);
    asm volatile("s_waitcnt vmcnt(0)" ::: "memory");
    __syncthreads();
    unsigned kbase[2], vbase[2];
#pragma unroll
    for (int e = 0; e < 2; ++e) { kbase[e] = 2048u * ((unsigned)q >> 3) + 64u * ((unsigned)q & 7u) + 16u * ((unsigned)(2 * e + hi) ^ (((unsigned)q >> 2) & 3u)); }
    const unsigned tq_ = (unsigned)(lane & 15) >> 2, tp = (unsigned)lane & 3u, tblk = ((unsigned)lane >> 4) & 1u;
#pragma unroll
    for (int t = 0; t < 2; ++t) vbase[t] = 64u * (4u * hi + tq_) + 16u * ((2u * tblk + (tp >> 1)) ^ ((unsigned)(2 * t + hi) & 3u)) + 8u * (tp & 1u);
    for (int j = 0; j < nt; ++j) {
        const int cur = j & 1, jt = nt - 1 - j; const bool more = (j + 1 < nt);
        if (more) AT_STAGE(jt - 1, cur ^ 1);
        const bool active = (64 * jt <= R0 + 31);
        if (active) {
            const LAS unsigned char* Kt = lds + AT_K0 + cur * 16384; const LAS unsigned char* Vt = lds + AT_V0 + cur * 16384;
            f32x16 s0, s1;
            if (MODE == 0) {
#pragma unroll
                for (int g = 0; g < 4; ++g) { const f32x4 a = *(const LAS f32x4*)(nlb + 64 * jt + 8 * g + 4 * hi), c = *(const LAS f32x4*)(nlb + 64 * jt + 32 + 8 * g + 4 * hi);
#pragma unroll
                    for (int e = 0; e < 4; ++e) { s0[4 * g + e] = a[e]; s1[4 * g + e] = c[e]; } }
            } else {
#pragma unroll
                for (int r = 0; r < 16; ++r) { s0[r] = 0.f; s1[r] = 0.f; }
            }
            {
                bf16x8 kf[16];
#pragma unroll
                for (int s = 0; s < 8; ++s) { const unsigned a = kbase[s & 1] + 512u * (unsigned)(s >> 1);
                    kf[2 * s] = *(const LAS bf16x8*)(Kt + a); kf[2 * s + 1] = *(const LAS bf16x8*)(Kt + a + 8192); }
                __builtin_amdgcn_sched_barrier(0);
#pragma unroll
                for (int s = 0; s < 8; ++s) {
                    s0 = __builtin_amdgcn_mfma_f32_32x32x16_bf16(kf[2 * s], qf[s], s0, 0, 0, 0);
                    s1 = __builtin_amdgcn_mfma_f32_32x32x16_bf16(kf[2 * s + 1], qf[s], s1, 0, 0, 0);
                }
            }
            s16x4 vv[4][2][2][2];
#pragma unroll
            for (int c = 0; c < 2; ++c)
#pragma unroll
                for (int blk = 0; blk < 2; ++blk)
#pragma unroll
                    for (int st = 0; st < 2; ++st)
#pragma unroll
                        for (int t = 0; t < 2; ++t) vv[c][blk][st][t] = vtr(Vt + vbase[t] + 2048u * (unsigned)(4 * blk + 2 * st + t) + 512u * (unsigned)c);
            __builtin_amdgcn_sched_barrier(0);
            if (64 * jt + 63 > R0) {
                const float NEG = MODE == 0 ? -__builtin_inff() : 0.f;
#pragma unroll
                for (int r = 0; r < 16; ++r) { const int key = 64 * jt + crow(r, hi); if (key > tq) s0[r] = NEG; if (key + 32 > tq) s1[r] = NEG; }
            }
            if (MODE == 0) {
                float pmax = s0[0];
#pragma unroll
                for (int r = 1; r < 16; ++r) pmax = fmaxf(pmax, s0[r]);
#pragma unroll
                for (int r = 0; r < 16; ++r) pmax = fmaxf(pmax, s1[r]);
                pmax = fmaxf(pmax, __shfl_xor(pmax, 32));
                const float mn = fmaxf(mrun, pmax);
                if (__any(mn > mrun)) {
                    const float alpha = __builtin_amdgcn_exp2f(mrun - mn); mrun = mn; lrun *= alpha;
#pragma unroll
                    for (int c = 0; c < 4; ++c)
#pragma unroll
                        for (int r = 0; r < 16; ++r) o[c][r] *= alpha;
                }
                float rs = 0.f;
#pragma unroll
                for (int r = 0; r < 16; ++r) { s0[r] = __builtin_amdgcn_exp2f(s0[r] - mrun); s1[r] = __builtin_amdgcn_exp2f(s1[r] - mrun); rs += s0[r] + s1[r]; }
                lrun += rs;
            }
            bf16x8 pf[2][2];
#pragma unroll
            for (int st = 0; st < 2; ++st) {
                v4u w0, w1;
                w0.x = pg8::cvt_pk_bf16(s0[8 * st + 0], s0[8 * st + 1]); w0.y = pg8::cvt_pk_bf16(s0[8 * st + 2], s0[8 * st + 3]); w0.z = pg8::cvt_pk_bf16(s0[8 * st + 4], s0[8 * st + 5]); w0.w = pg8::cvt_pk_bf16(s0[8 * st + 6], s0[8 * st + 7]);
                w1.x = pg8::cvt_pk_bf16(s1[8 * st + 0], s1[8 * st + 1]); w1.y = pg8::cvt_pk_bf16(s1[8 * st + 2], s1[8 * st + 3]); w1.z = pg8::cvt_pk_bf16(s1[8 * st + 4], s1[8 * st + 5]); w1.w = pg8::cvt_pk_bf16(s1[8 * st + 6], s1[8 * st + 7]);
                pf[0][st] = __builtin_bit_cast(bf16x8, w0); pf[1][st] = __builtin_bit_cast(bf16x8, w1);
            }
#pragma unroll
            for (int c = 2; c < 4; ++c)
#pragma unroll
                for (int blk = 0; blk < 2; ++blk)
#pragma unroll
                    for (int st = 0; st < 2; ++st)
#pragma unroll
                        for (int t = 0; t < 2; ++t) vv[c][blk][st][t] = vtr(Vt + vbase[t] + 2048u * (unsigned)(4 * blk + 2 * st + t) + 512u * (unsigned)c);
            __builtin_amdgcn_sched_barrier(0);
#pragma unroll
            for (int c = 0; c < 4; ++c)
#pragma unroll
                for (int blk = 0; blk < 2; ++blk)
#pragma unroll
                    for (int st = 0; st < 2; ++st) {
                        const s16x4 v0 = vv[c][blk][st][0], v1 = vv[c][blk][st][1];
                        bf16x8 vf; vf[0] = v0[0]; vf[1] = v0[1]; vf[2] = v0[2]; vf[3] = v0[3]; vf[4] = v1[0]; vf[5] = v1[1]; vf[6] = v1[2]; vf[7] = v1[3];
                        o[c] = __builtin_amdgcn_mfma_f32_32x32x16_bf16(vf, pf[blk][st], o[c], 0, 0, 0);
                    }
        }
        asm volatile("s_waitcnt vmcnt(0)" ::: "memory");
        __syncthreads();
    }
#undef AT_STAGE
    bf16* Yg = (bf16*)(ws + WS_BRA + (MODE ? 2 : 1) * SZ_ACT) + (rowbase + tq) * WIDE + h * HD;
    if (MODE == 0) {
        const float lt = lrun + __shfl_xor(lrun, 32), inv = 1.0f / lt;
#pragma unroll
        for (int c = 0; c < 4; ++c)
#pragma unroll
            for (int g = 0; g < 4; ++g) { v2u w; w.x = pg8::cvt_pk_bf16(o[c][4 * g] * inv, o[c][4 * g + 1] * inv); w.y = pg8::cvt_pk_bf16(o[c][4 * g + 2] * inv, o[c][4 * g + 3] * inv);
                *(GAS v2u*)(Yg + 32 * c + 8 * g + 4 * hi) = w; }
    } else {
        float sm = 0.f;
#pragma unroll
        for (int c = 0; c < 4; ++c)
#pragma unroll
            for (int r = 0; r < 16; ++r) sm += o[c][r];
        sm += __shfl_xor(sm, 32);
        const float mu = sm * (1.0f / 128.0f); float vs = 0.f;
#pragma unroll
        for (int c = 0; c < 4; ++c)
#pragma unroll
            for (int r = 0; r < 16; ++r) { const float d = o[c][r] - mu; vs += d * d; }
        vs += __shfl_xor(vs, 32);
        const float rstd = 1.0f / sqrtf(vs * (1.0f / 128.0f) + 1e-5f);
        const bf16* Gg = (const bf16*)(ws + WS_RG) + (rowbase + tq) * WIDE + h * HD;
#pragma unroll
        for (int c = 0; c < 4; ++c)
#pragma unroll
            for (int g = 0; g < 4; ++g) { const v2u gw = *(const GAS v2u*)(Gg + 32 * c + 8 * g + 4 * hi);
                const float g0 = __uint_as_float(gw.x << 16), g1 = __uint_as_float(gw.x & 0xffff0000u), g2 = __uint_as_float(gw.y << 16), g3 = __uint_as_float(gw.y & 0xffff0000u);
                v2u w; w.x = pg8::cvt_pk_bf16((o[c][4 * g] - mu) * rstd * g0, (o[c][4 * g + 1] - mu) * rstd * g1); w.y = pg8::cvt_pk_bf16((o[c][4 * g + 2] - mu) * rstd * g2, (o[c][4 * g + 3] - mu) * rstd * g3);
                *(GAS v2u*)(Yg + 32 * c + 8 * g + 4 * hi) = w; }
    }
}

__device__ __forceinline__ void mix_unit(unsigned char* ws, const float* fbias_l, LAS unsigned char* lds, int b, int h, int qb, int wave, int lane, int tid) {
    mix_nlb(ws, fbias_l, lds, b, h, wave, lane, tid);
    if (wave < 4) mix_half<0>(ws, lds, b, h, qb, wave, lane); else mix_half<1>(ws, lds, b, h, qb, wave - 4, lane);
}

__device__ __forceinline__ void unpack8(const v4u x, float (&f)[8]) {
    f[0] = __uint_as_float(x.x << 16); f[1] = __uint_as_float(x.x & 0xffff0000u); f[2] = __uint_as_float(x.y << 16); f[3] = __uint_as_float(x.y & 0xffff0000u);
    f[4] = __uint_as_float(x.z << 16); f[5] = __uint_as_float(x.z & 0xffff0000u); f[6] = __uint_as_float(x.w << 16); f[7] = __uint_as_float(x.w & 0xffff0000u); }
template <int W>
__device__ __forceinline__ void pool_rows(const bf16* U, bf16* P, int r0, int c0) {
    const int t0 = r0 & (SEQ - 1);
    v4u x[7 + W];
#pragma unroll
    for (int i = 0; i < 7 + W; ++i) { const int dr = i - (W - 1); x[i] = (t0 + dr >= 0) ? *(const GAS v4u*)(U + (size_t)(r0 + dr) * WIDE + c0) : (v4u){0u, 0u, 0u, 0u}; }
    float s[8];
#pragma unroll
    for (int e = 0; e < 8; ++e) s[e] = 0.f;
#pragma unroll
    for (int i = 0; i < W - 1; ++i) { float f[8]; unpack8(x[i], f);
#pragma unroll
        for (int e = 0; e < 8; ++e) s[e] += f[e]; }
#pragma unroll
    for (int i = 0; i < 8; ++i) {
        float cur[8]; unpack8(x[W - 1 + i], cur);
#pragma unroll
        for (int e = 0; e < 8; ++e) s[e] += cur[e];
        const int t = t0 + i; const float ic = 1.0f / (float)((t + 1 < W) ? t + 1 : W);
        v4u o; o.x = pk2(s[0] * ic - cur[0], s[1] * ic - cur[1]); o.y = pk2(s[2] * ic - cur[2], s[3] * ic - cur[3]); o.z = pk2(s[4] * ic - cur[4], s[5] * ic - cur[5]); o.w = pk2(s[6] * ic - cur[6], s[7] * ic - cur[7]);
        *(GAS v4u*)(P + (size_t)(r0 + i) * WIDE + c0) = o;
        float old[8]; unpack8(x[i], old);
#pragma unroll
        for (int e = 0; e < 8; ++e) s[e] -= old[e];
    }
}
__device__ __forceinline__ void pool_item(unsigned char* ws, int item, int wave, int lane) {
    const bf16* U = (const bf16*)(ws + WS_U); bf16* P = (bf16*)(ws + WS_BRA);
    const int g = wave & 3, c0 = g * 256 + (lane & 31) * 8, r0 = item * 64 + ((wave >> 2) * 2 + (lane >> 5)) * 16;
#pragma unroll 1
    for (int hp = 0; hp < 2; ++hp) { const int r = r0 + 8 * hp;
        if (g == 0) pool_rows<2>(U, P, r, c0); else if (g == 1) pool_rows<4>(U, P, r, c0); else if (g == 2) pool_rows<8>(U, P, r, c0); else pool_rows<16>(U, P, r, c0); }
}

__global__ void __launch_bounds__(NWAVES * 64, 2) mk_fwd(Args args) {
    extern __shared__ __attribute__((aligned(16))) unsigned char lds_raw[];
    LAS unsigned char* lds = (LAS unsigned char*)lds_raw;
    volatile LAS unsigned* MISC = (volatile LAS unsigned*)(lds + MISC_OFF);
    const int tid0 = threadIdx.x;
#define OPAQUE_TID() int tid = tid0; asm volatile("" : "+v"(tid)); const int lane = tid & 63, wave = __builtin_amdgcn_readfirstlane(tid >> 6); (void)lane; (void)wave
    const int G = gridDim.x;
    unsigned char* ws = args.ws;
    gu32* ctl = (gu32*)(ws + WS_CTL);
    for (int u = tid0; u < (LDS_BYTES - LDSCTL_OFF) / 4; u += NWAVES * 64) ((LAS unsigned*)(lds + LDSCTL_OFF))[u] = 0u;
    __syncthreads();
#if MK_PER_PHASE
    XcdBarrier bar; bar.bar = (unsigned*)(ctl + CW_BAR); bar.x = 0; bar.st = nullptr;
#define GRID_BAR() do { if (tid0 == 0) __hip_atomic_store(ctl + CW_TMO, 0xBADBA0u, RLX_AGENT); } while (0)
#else
    XcdBarrier bar = xcd_barrier_post((unsigned*)(ctl + CW_BAR), MISC + 8);
#define GRID_BAR() xcd_barrier(bar)
#endif
    const int lo = args.ph_lo, hi = args.ph_hi;
    int p = 0;
#define IN(k) (lo <= (k) && (k) < hi)
#ifndef MK_OFF
#define MK_OFF 0
#endif
#define PH_ON(n) (!((MK_OFF) & (1 << (n))))
#ifndef MK_DUP
#define MK_DUP 0
#endif
#define NREP(n) ((((MK_DUP) >> (n)) & 1) ? 2 : 1)
#ifndef MK_BAR2
#define MK_BAR2 0
#endif
#define SEAM() do { if (IN(p) && IN(p + 1)) { GRID_BAR(); if (MK_BAR2) GRID_BAR(); } ++p; } while (0)

    bf16* XB = (bf16*)(ws + WS_XB); float* X = (float*)(ws + WS_X); float* SS = (float*)(ws + WS_SS);

    if (PH_ON(0) && IN(p)) for (int rep = 0; rep < NREP(0); ++rep) { OPAQUE_TID(); p0_prologue(args, lds, wave, lane, tid, G); if (rep + 1 < NREP(0)) GRID_BAR(); }
    SEAM();

    if (PH_ON(8) && IN(p)) {
        pg8::Gemm g{(const bf16*)(ws + WS_WBPT), (const bf16*)(ws + WS_WP), 16 * D, 16 * 256, 256}; pg8::FoldOrder S{(int)blockIdx.x};
        pg8::EpiFold E{(bf16*)(ws + WS_WBR), SZ_WBR / 2};
        for (int rep = 0; rep < NREP(8); ++rep) { pg8::gemm_phase<pg8::EpiFold, pg8::FoldOrder, false, true>(lds + RING_OFF, g, S, E); if (rep + 1 < NREP(8)) GRID_BAR(); }
    }
    SEAM();

    for (int j = 0; j < 2 * DEPTH; ++j) {
        const int l = j >> 1;
        if (PH_ON(1) && IN(p)) {
            pg8::Gemm g{XB, (const bf16*)(ws + WS_W13T + (size_t)j * SZ_W13T), M, 2 * DFF, D}; pg8::StaticOrder S; S.init(M, 2 * DFF, G, (int)blockIdx.x); S.rounds = 5;
            pg8::EpiSwiGLU<false> E{(bf16*)(ws + WS_H), SS, DFF};
            pg8::HalfTailOrder ST; ST.so.init(M, 2 * DFF, G, (int)blockIdx.x >> 1); ST.half = (int)blockIdx.x & 1; ST.full_rounds = 5;
            pg8::EpiSwiGLU<true> ET{(bf16*)(ws + WS_H), SS, DFF};
            for (int rep = 0; rep < NREP(1); ++rep) {
                pg8::gemm_phase<pg8::EpiSwiGLU<false>, pg8::StaticOrder, true, true>(lds + RING_OFF, g, S, E);
                pg8::gemm_phase<pg8::EpiSwiGLU<true>, pg8::HalfTailOrder, true, true, true>(lds + RING_OFF, g, ST, ET);
                if (rep + 1 < NREP(1)) GRID_BAR(); }
        }
        SEAM();
        if (PH_ON(2) && IN(p)) {
            pg8::Gemm g{(const bf16*)(ws + WS_H), (const bf16*)(ws + WS_W2T + (size_t)j * SZ_W2T), M, D, DFF}; pg8::StaticOrder S; S.init(M, D, G, (int)blockIdx.x);
            for (int rep = 0; rep < NREP(2); ++rep) { pg8::EpiResid E{j == 0 ? args.in[I_X] : (const float*)X, X, XB, SS, rep + 1 < NREP(2) ? 0.0f : 0.5f};
                pg8::gemm_phase<pg8::EpiResid, pg8::StaticOrder, false, true>(lds + RING_OFF, g, S, E); if (rep + 1 < NREP(2)) GRID_BAR(); }
        }
        SEAM();
        if (j & 1) continue;
        if (PH_ON(3) && IN(p)) {
            for (int rep = 0; rep < NREP(9); ++rep) { OPAQUE_TID(); flogit_rows(ws, l, wave, lane); }
            pg8::Gemm g{XB, (const bf16*)(ws + WS_WINT + (size_t)l * SZ_WINT), M, WIN_N, D}; pg8::StaticOrder S; S.init(M, WIN_N, G, (int)blockIdx.x);
            pg8::EpiWin E{SS, (bf16*)(ws + WS_U), (bf16*)(ws + WS_FQ), (bf16*)(ws + WS_FK), (bf16*)(ws + WS_FV), (bf16*)(ws + WS_RQ), (bf16*)(ws + WS_RK), (bf16*)(ws + WS_RV), (bf16*)(ws + WS_RG), (bf16*)(ws + WS_GATES),
                          (const float*)(ws + WS_COS), (const float*)(ws + WS_SIN)};
            for (int rep = 0; rep < NREP(3); ++rep) { pg8::gemm_phase<pg8::EpiWin, pg8::StaticOrder, true, true>(lds + RING_OFF, g, S, E); if (rep + 1 < NREP(3)) GRID_BAR(); }
        }
        SEAM();
        if (PH_ON(4) && IN(p)) {
            OPAQUE_TID();
            const float* fb = args.in[I_FB] + l * NH;
            for (int rep = 0; rep < NREP(4); ++rep) {
            gu32* head = ctl + CW_QUEUE + 64 * l + 512 * rep;
            for (;;) {
                __syncthreads();
                if (tid == 0) MISC[0] = __hip_atomic_fetch_add(head, 1u, RLX_AGENT);
                __syncthreads();
                const int it = (int)MISC[0];
                if (it >= 512 + 128) break;
                if (it < 512) { const int qb = 15 - (it >> 5), bh = it & 31; mix_unit(ws, fb, lds, bh >> 3, bh & 7, qb, wave, lane, tid); }
                else pool_item(ws, it - 512, wave, lane);
            }
            if (rep + 1 < NREP(4)) GRID_BAR(); }
        }
        SEAM();
        if (PH_ON(5) && IN(p)) {
            pg8::Gemm g{(const bf16*)(ws + WS_BRA), (const bf16*)(ws + WS_WBR + (size_t)l * SZ_WBR), 3 * M, 3 * D, WIDE}; pg8::BranchOrder S; S.so.init(M, D, G, (int)blockIdx.x);
            pg8::EpiBranch E{(const bf16*)(ws + WS_GATES), (bf16*)(ws + WS_MGB)};
            for (int rep = 0; rep < NREP(5); ++rep) { pg8::gemm_phase<pg8::EpiBranch, pg8::BranchOrder, true, true>(lds + RING_OFF, g, S, E); if (rep + 1 < NREP(5)) GRID_BAR(); }
        }
        SEAM();
        if (PH_ON(6) && IN(p)) {
            pg8::Gemm g{(const bf16*)(ws + WS_MGB), (const bf16*)(ws + WS_WOUT + (size_t)l * SZ_WOUT), M, D, D}; pg8::StaticOrder S; S.init(M, D, G, (int)blockIdx.x);
            for (int rep = 0; rep < NREP(6); ++rep) { pg8::EpiResid E{(const float*)X, X, XB, SS, rep + 1 < NREP(6) ? 0.0f : 1.0f};
                pg8::gemm_phase<pg8::EpiResid, pg8::StaticOrder, false, true>(lds + RING_OFF, g, S, E); if (rep + 1 < NREP(6)) GRID_BAR(); }
        }
        SEAM();
    }
    if (PH_ON(7) && IN(p)) {
        OPAQUE_TID();
        const unsigned bad = __hip_atomic_load(ctl + CW_TMO, RLX_AGENT) | __hip_atomic_load(ctl + CW_BAR + XB_TMO, RLX_AGENT);
        const float* gf = args.in[I_FINN];
        for (int rep = 0; rep < NREP(7); ++rep)
        for (int m = (int)blockIdx.x * NWAVES + wave; m < M; m += G * NWAVES) {
            const float rs = bad ? __builtin_nanf("") : pg8::row_rstd(SS, m);
            const GAS f32x4* xr = (const GAS f32x4*)(X + (size_t)m * D) + lane; GAS f32x4* orow = (GAS f32x4*)(args.out + (size_t)m * D) + lane;
#pragma unroll
            for (int k = 0; k < 8; ++k) { const f32x4 v = xr[64 * k], gv = *((const GAS f32x4*)gf + lane + 64 * k); orow[64 * k] = v * rs * gv; }
        }
    }
#undef IN
#undef SEAM
#undef GRID_BAR
}

extern "C" void kernel_launch(void* const* d_in, const int* in_sizes, int n_in, void* d_out, int out_size, void* d_ws, size_t ws_size, hipStream_t stream) {
    static int grid = 0;
    if (grid == 0) {
        if (n_in != 17 || in_sizes[0] != M * D || out_size != M * D || ws_size < WS_END) { fprintf(stderr, "kernel_launch: unexpected shapes (n_in %d, in0 %d, out %d, ws %zu < %zu); nothing launched\n", n_in, n_in > 0 ? in_sizes[0] : -1, out_size, ws_size, (size_t)WS_END); grid = -1; return; }
        int dev = 0, cus = 0, per_cu = 0;
        if (hipGetDevice(&dev) != hipSuccess || hipDeviceGetAttribute(&cus, hipDeviceAttributeMultiprocessorCount, dev) != hipSuccess) { grid = -1; return; }
        if (hipFuncSetAttribute((const void*)mk_fwd, hipFuncAttributeMaxDynamicSharedMemorySize, LDS_BYTES) != hipSuccess) { fprintf(stderr, "kernel_launch: hipFuncSetAttribute failed\n"); grid = -1; return; }
        if (hipOccupancyMaxActiveBlocksPerMultiprocessor(&per_cu, (const void*)mk_fwd, NWAVES * 64, LDS_BYTES) != hipSuccess || per_cu < 1) { fprintf(stderr, "kernel_launch: occupancy query says %d workgroups per CU\n", per_cu); }
        (void)hipGetLastError();
        if (cus != 256) { fprintf(stderr, "kernel_launch: built for 256 CUs, device has %d; nothing launched\n", cus); grid = -1; return; }
        grid = 256;
    }
    if (grid < 0) return;
    if (hipMemsetAsync((char*)d_ws + WS_CTL, 0, CTL_ZERO_BYTES, stream) != hipSuccess) return;
    Args a{};
    for (int i = 0; i < 17; ++i) a.in[i] = (const float*)d_in[i];
    a.out = (float*)d_out; a.ws = (unsigned char*)d_ws;
#if MK_PER_PHASE
    for (int li = 0; li < N_PHASES; ++li) { a.ph_lo = li; a.ph_hi = li + 1; a.li = li; hipLaunchKernelGGL(mk_fwd, dim3(grid), dim3(NWAVES * 64), LDS_BYTES, stream, a); }
#else
    a.ph_lo = 0; a.ph_hi = N_PHASES; a.li = 0;
    hipLaunchKernelGGL(mk_fwd, dim3(grid), dim3(NWAVES * 64), LDS_BYTES, stream, a);
#endif
    const hipError_t le = hipPeekAtLastError();
    if (le != hipSuccess) fprintf(stderr, "kernel_launch: launch failed: %s\n", hipGetErrorName(le));
}
```

```cpp
#include <hip/hip_runtime.h>
#include <cstdio>
#include <cstdint>
#include <cmath>
namespace pg8 {
#define PG8_LAS __attribute__((address_space(3)))
typedef unsigned short bf16_t;
typedef short bf16x8 __attribute__((ext_vector_type(8)));
typedef float f32x4 __attribute__((ext_vector_type(4)));
typedef unsigned u32x4 __attribute__((ext_vector_type(4)));
constexpr int BM = 256, BK = 64, HALF = 128, HTB = HALF * BK * 2  , STAGE_BYTES = 8 * HTB, NXCD = 8, WGM = 8;

__host__ __device__ __forceinline__ int lds_byte(int r, int c) { const int st = (r >> 4) * 2 + (c >> 5), rr = r & 15, cc = c & 31, ob = rr * 64 + cc * 2; return st * 1024 + (ob ^ (((ob >> 9) & 1) << 5)); }
__host__ __device__ __forceinline__ void stage_rc(int b, int& R, int& C) { const int st = b / 1024, sb = b % 1024, swz = sb ^ (((sb >> 9) & 1) << 5); R = (st >> 1) * 16 + swz / 64; C = (st & 1) * 32 + (swz % 64) / 2; }
__host__ __device__ __forceinline__ int perm32(int rho) { const int n = rho >> 4, i = rho & 15; return 8 * (i >> 2) + 4 * n + (i & 3); }

struct Unit { int pm, pn; };
struct Gemm { const bf16_t* A; const bf16_t* Bt; int M, N, K; };

struct StaticOrder {
    int nM, nN, nwg, G, c, rounds;
    __host__ __device__ void init(int M, int N, int G_, int c_) { nM = M / BM; nN = N / BM; nwg = nM * nN; G = G_; c = c_; rounds = 1 << 30; }
    __host__ __device__ bool next(int i, Unit& u) const {
        const long L = (long)i * G + c; if (L >= nwg || i >= rounds) return false;
        int wgid = (int)L; { const int q = nwg / NXCD, r = nwg % NXCD, xcd = wgid % NXCD, off = wgid / NXCD; wgid = (xcd < r ? xcd * (q + 1) : r * (q + 1) + (xcd - r) * q) + off; }
        const int nig = WGM * nN, gid = wgid / nig, fm = gid * WGM, gsz = (nM - fm) < WGM ? (nM - fm) : WGM;
        u.pm = fm + ((wgid % nig) % gsz); u.pn = (wgid % nig) / gsz; return true;
    }
    __device__ __forceinline__ void a_ready(const Unit&) const {}
    __device__ __forceinline__ void done(const Unit&) const {}
};

__device__ __forceinline__ unsigned cvt_pk_bf16(float lo, float hi) { unsigned r; asm volatile("v_cvt_pk_bf16_f32 %0, %1, %2" : "=v"(r) : "v"(lo), "v"(hi)); return r; }
typedef float f32x2 __attribute__((ext_vector_type(2)));
typedef unsigned u32x2v __attribute__((ext_vector_type(2)));
constexpr int DM = 2048;
constexpr float LOG2E = 1.4426950408889634f;
__device__ __forceinline__ float fast_sigmoid(float x) { return __builtin_amdgcn_rcpf(1.0f + __builtin_amdgcn_exp2f(-x * LOG2E)); }
__device__ __forceinline__ float fast_silu(float x) { return x * fast_sigmoid(x); }
__device__ __forceinline__ float gate_sig(float x) { return fmaxf(fast_sigmoid(x), 1e-18f); }
__device__ __forceinline__ u32x4 pack8(const f32x4 a, const f32x4 b) { u32x4 w; w.x = cvt_pk_bf16(a[0], a[1]); w.y = cvt_pk_bf16(a[2], a[3]); w.z = cvt_pk_bf16(b[0], b[1]); w.w = cvt_pk_bf16(b[2], b[3]); return w; }
__device__ __forceinline__ f32x4 bf_lo4(const u32x4 w) { return (f32x4){__uint_as_float(w.x << 16), __uint_as_float(w.x & 0xffff0000u), __uint_as_float(w.y << 16), __uint_as_float(w.y & 0xffff0000u)}; }
__device__ __forceinline__ f32x4 bf_hi4(const u32x4 w) { return (f32x4){__uint_as_float(w.z << 16), __uint_as_float(w.z & 0xffff0000u), __uint_as_float(w.w << 16), __uint_as_float(w.w & 0xffff0000u)}; }
__device__ __forceinline__ float row_rstd(const float* ss, int row) {
    const f32x4 a = *(const f32x4*)(ss + (size_t)row * 8), b = *(const f32x4*)(ss + (size_t)row * 8 + 4);
    const float s = ((a[0] + a[1]) + (a[2] + a[3])) + ((b[0] + b[1]) + (b[2] + b[3]));
    return 1.0f / sqrtf(s * (1.0f / (float)DM) + 1e-6f);
}

__device__ __forceinline__ void wave_rstd(const float* ss, int rowbase, int lane, int fr, float (&rs)[2][4]) {
    const float r0 = row_rstd(ss, rowbase + lane), r1 = row_rstd(ss, rowbase + HALF + lane);
#pragma unroll
    for (int m = 0; m < 4; ++m) { rs[0][m] = __shfl(r0, m * 16 + fr); rs[1][m] = __shfl(r1, m * 16 + fr); }
}

template <bool HALFM = false>
struct EpiSwiGLU {
    static constexpr bool PERM = true, AFTER_DRAIN = false, KEEP_ACC = false;
    bf16_t* H; const float* ss; int ldh;
    __device__ __forceinline__ void operator()(const f32x4 (&acc)[2][2][4][2], const Unit& u, int wr, int wc, int fr, int fq) const {
        const int rowb = u.pm * (HALFM ? HALF : BM) + wr * 64, row0 = rowb + fr, col0 = u.pn * HALF + wc * 32 + 8 * fq;
        float rsv[2][4]; wave_rstd(ss, rowb, fq * 16 + fr, fr, rsv);
#pragma unroll
        for (int ai = 0; ai < (HALFM ? 1 : 2); ++ai)
#pragma unroll
            for (int m = 0; m < 4; ++m) {
                const int row = row0 + ai * HALF + m * 16; const float rs = rsv[ai][m];
                f32x4 h[2];
#pragma unroll
                for (int n = 0; n < 2; ++n) { const f32x4 a = acc[ai][0][m][n] * rs, b = acc[ai][1][m][n] * rs;
                    h[n] = (f32x4){fast_silu(a[0]) * b[0], fast_silu(a[1]) * b[1], fast_silu(a[2]) * b[2], fast_silu(a[3]) * b[3]}; }
                *(u32x4*)(H + (size_t)row * ldh + col0) = pack8(h[0], h[1]);
                asm volatile("" ::: "memory");
            }
    }
};

struct EpiResid {
    static constexpr bool PERM = true, AFTER_DRAIN = true, KEEP_ACC = false;
    const float* xin32; const bf16_t* xinb; bf16_t* xb; float* ss; float coef;
    __device__ __forceinline__ void fused(f32x4 (&acc)[2][2][4][2], const Unit& u, int wr, int wc, int fr, int fq, PG8_LAS unsigned char* lds, int wid, int lane) const {
        PG8_LAS float* P = (PG8_LAS float*)lds;
        const int row0 = u.pm * BM + wr * 64 + fr, col0 = u.pn * BM + wc * 32 + 8 * fq;
#pragma unroll
        for (int ai = 0; ai < 2; ++ai) {
            f32x4 xv[4][2][2];
            if (xin32) {
#pragma unroll
                for (int m = 0; m < 4; ++m)
#pragma unroll
                    for (int bj = 0; bj < 2; ++bj) { const size_t off = (size_t)(row0 + ai * HALF + m * 16) * DM + col0 + bj * HALF; xv[m][bj][0] = *(const f32x4*)(xin32 + off); xv[m][bj][1] = *(const f32x4*)(xin32 + off + 4); }
            } else {
                u32x4 xw[4][2];
#pragma unroll
                for (int m = 0; m < 4; ++m)
#pragma unroll
                    for (int bj = 0; bj < 2; ++bj) xw[m][bj] = *(const u32x4*)(xinb + (size_t)(row0 + ai * HALF + m * 16) * DM + col0 + bj * HALF);
                asm volatile("" ::: "memory");
#pragma unroll
                for (int m = 0; m < 4; ++m)
#pragma unroll
                    for (int bj = 0; bj < 2; ++bj) { xv[m][bj][0] = bf_lo4(xw[m][bj]); xv[m][bj][1] = bf_hi4(xw[m][bj]); }
            }
            asm volatile("" ::: "memory");
#pragma unroll
            for (int m = 0; m < 4; ++m) {
                const int row = row0 + ai * HALF + m * 16; float sq = 0.f;
#pragma unroll
                for (int bj = 0; bj < 2; ++bj) { const size_t off = (size_t)row * DM + col0 + bj * HALF;
                    f32x4 v0 = xv[m][bj][0], v1 = xv[m][bj][1];
                    v0 = v0 + acc[ai][bj][m][0] * coef; v1 = v1 + acc[ai][bj][m][1] * coef;
                    *(u32x4*)(xb + off) = pack8(v0, v1);
                    sq += ((v0[0] * v0[0] + v0[1] * v0[1]) + (v0[2] * v0[2] + v0[3] * v0[3])) + ((v1[0] * v1[0] + v1[1] * v1[1]) + (v1[2] * v1[2] + v1[3] * v1[3])); }
                sq += __shfl_xor(sq, 16); sq += __shfl_xor(sq, 32);
                if (fq == 0) P[(ai * HALF + wr * 64 + m * 16 + fr) * 4 + wc] = sq;
            }
            asm volatile("" ::: "memory");
        }
        asm volatile("s_waitcnt lgkmcnt(0)" ::: "memory"); __builtin_amdgcn_s_barrier(); asm volatile("" ::: "memory");
        const int t = wid * 64 + lane;
        if (t < 256) { const f32x4 p = *(const PG8_LAS f32x4*)(P + t * 4); ss[(size_t)(u.pm * BM + t) * 8 + u.pn] = (p[0] + p[1]) + (p[2] + p[3]); }
        asm volatile("s_waitcnt lgkmcnt(0)" ::: "memory"); __builtin_amdgcn_s_barrier(); asm volatile("" ::: "memory");
    }
};

struct EpiWin {
    static constexpr bool PERM = true, AFTER_DRAIN = false, KEEP_ACC = false;
    const float* ss; bf16_t *U, *FQ, *FK, *FV, *RQ, *RK, *RV, *RG, *GATES; const float *rcos, *rsin;
    __device__ __forceinline__ void operator()(const f32x4 (&acc)[2][2][4][2], const Unit& u, int wr, int wc, int fr, int fq) const {
        const int row0 = u.pm * BM + wr * 64 + fr; const int reg = u.pn >> 2;
        if (reg == 4 || reg == 5) {
            const int head = 2 * (u.pn & 3) + (wc >> 1), j0 = 32 * (wc & 1) + 8 * fq;
            const float lg = log2f(1.0f - exp2f(-5.0f - (float)head));
            bf16_t* dst = (reg == 4) ? RQ : RK;
            float rsv[2][4]; wave_rstd(ss, u.pm * BM + wr * 64, fq * 16 + fr, fr, rsv);
#pragma unroll
            for (int ai = 0; ai < 2; ++ai)
#pragma unroll
                for (int mp = 0; mp < 2; ++mp) {
                    f32x4 cs[2][2], sn[2][2];
#pragma unroll
                    for (int mm = 0; mm < 2; ++mm) { const int t = (row0 + ai * HALF + (2 * mp + mm) * 16) & 2047;
#pragma unroll
                        for (int n = 0; n < 2; ++n) { cs[mm][n] = *(const f32x4*)(rcos + t * 64 + j0 + 4 * n); sn[mm][n] = *(const f32x4*)(rsin + t * 64 + j0 + 4 * n); } }
                    asm volatile("" ::: "memory");
#pragma unroll
                    for (int mm = 0; mm < 2; ++mm) { const int m = 2 * mp + mm, row = row0 + ai * HALF + m * 16, t = row & 2047;
                        const float sc = rsv[ai][m] * ((reg == 4) ? exp2f((float)t * lg) * 0.08838834764831845f : exp2f(-(float)t * lg));
                        f32x4 o1[2], o2[2];
#pragma unroll
                        for (int n = 0; n < 2; ++n) { const f32x4 x1 = acc[ai][0][m][n] * sc, x2 = acc[ai][1][m][n] * sc; o1[n] = x1 * cs[mm][n] - x2 * sn[mm][n]; o2[n] = x1 * sn[mm][n] + x2 * cs[mm][n]; }
                        bf16_t* p = dst + (size_t)row * 1024 + head * 128 + j0;
                        *(u32x4*)p = pack8(o1[0], o1[1]); *(u32x4*)(p + 64) = pack8(o2[0], o2[1]); }
                    asm volatile("" ::: "memory");
                }
            return;
        }
        bf16_t* dst; int ldc, colt; int act = 0; float mul = 1.f;
        if (reg < 8) { ldc = 1024; colt = (u.pn & 3) * BM;
            dst = reg == 0 ? U : reg == 1 ? FQ : reg == 2 ? FK : reg == 3 ? FV : reg == 6 ? RV : RG;
            if (reg == 1) mul = 0.08838834764831845f * LOG2E;
            if (reg == 7) act = 1; }
        else { ldc = 6144; colt = (u.pn - 32) * BM; dst = GATES; act = 2; }
        const int col0 = colt + wc * 32 + 8 * fq;
        float rsv[2][4]; wave_rstd(ss, u.pm * BM + wr * 64, fq * 16 + fr, fr, rsv);
#pragma unroll
        for (int ai = 0; ai < 2; ++ai)
#pragma unroll
            for (int m = 0; m < 4; ++m) {
                const int row = row0 + ai * HALF + m * 16; const float rs = rsv[ai][m] * mul;
#pragma unroll
                for (int bj = 0; bj < 2; ++bj) { f32x4 v0 = acc[ai][bj][m][0] * rs, v1 = acc[ai][bj][m][1] * rs;
                    if (act == 1) { v0 = (f32x4){fast_silu(v0[0]), fast_silu(v0[1]), fast_silu(v0[2]), fast_silu(v0[3])}; v1 = (f32x4){fast_silu(v1[0]), fast_silu(v1[1]), fast_silu(v1[2]), fast_silu(v1[3])}; }
                    if (act == 2) { v0 = (f32x4){gate_sig(v0[0]), gate_sig(v0[1]), gate_sig(v0[2]), gate_sig(v0[3])}; v1 = (f32x4){gate_sig(v1[0]), gate_sig(v1[1]), gate_sig(v1[2]), gate_sig(v1[3])}; }
                    *(u32x4*)(dst + (size_t)row * ldc + col0 + bj * HALF) = pack8(v0, v1); }
                asm volatile("" ::: "memory");
            }
    }
};

struct EpiBranch {
    static constexpr bool PERM = true, AFTER_DRAIN = false, KEEP_ACC = true;
    const bf16_t* GATES; bf16_t* MGB;
    __device__ __forceinline__ void operator()(f32x4 (&acc)[2][2][4][2], const Unit& u, int wr, int wc, int fr, int fq) const {
        const int br = u.pm >> 5, pm = u.pm & 31, pn = u.pn & 7;
        const int row0 = pm * BM + wr * 64 + fr, col0 = pn * BM + wc * 32 + 8 * fq;
#pragma unroll
        for (int ai = 0; ai < 2; ++ai) {
            u32x4 gc[4][2], gx[4][2];
#pragma unroll
            for (int m = 0; m < 4; ++m)
#pragma unroll
                for (int bj = 0; bj < 2; ++bj) { const bf16_t* gp = GATES + (size_t)(row0 + ai * HALF + m * 16) * 6144 + br * DM + col0 + bj * HALF;
                    gc[m][bj] = *(const u32x4*)gp; gx[m][bj] = (br < 2) ? *(const u32x4*)(gp + DM) : gc[m][bj]; }
            asm volatile("" ::: "memory");
#pragma unroll
            for (int m = 0; m < 4; ++m) {
                const int row = row0 + ai * HALF + m * 16;
#pragma unroll
                for (int bj = 0; bj < 2; ++bj) {
                    const u32x4 g = gc[m][bj]; f32x4 s0 = bf_lo4(g), s1 = bf_hi4(g);
                    if (br < 2) { const u32x4 gn = gx[m][bj]; s0 = s0 / bf_lo4(gn); s1 = s1 / bf_hi4(gn);
                        acc[ai][bj][m][0] = acc[ai][bj][m][0] * s0; acc[ai][bj][m][1] = acc[ai][bj][m][1] * s1; }
                    else { *(u32x4*)(MGB + (size_t)row * DM + col0 + bj * HALF) = pack8(acc[ai][bj][m][0] * s0, acc[ai][bj][m][1] * s1);
                        acc[ai][bj][m][0] = (f32x4){0.f, 0.f, 0.f, 0.f}; acc[ai][bj][m][1] = (f32x4){0.f, 0.f, 0.f, 0.f}; } }
            }
            asm volatile("" ::: "memory");
        }
    }
};
struct HalfTailOrder {
    StaticOrder so; int half, full_rounds;
    __device__ bool next(int i, Unit& u) const { if (i > 0) return false; StaticOrder s2 = so; s2.rounds = 1 << 30; Unit t; if (!s2.next(full_rounds, t)) return false; u.pm = 2 * t.pm + half; u.pn = t.pn; return true; }
    __device__ __forceinline__ void a_ready(const Unit&) const {}
    __device__ __forceinline__ void done(const Unit&) const {}
};
struct BranchOrder {
    StaticOrder so;
    __device__ bool next(int i, Unit& u) const { if (i >= 3) return false; Unit t; if (!so.next(0, t)) return false; u.pm = i * 32 + t.pm; u.pn = i * 8 + t.pn; return true; }
    __device__ __forceinline__ void a_ready(const Unit&) const {}
    __device__ __forceinline__ void done(const Unit&) const {}
};

struct EpiFold {
    static constexpr bool PERM = true, AFTER_DRAIN = false, KEEP_ACC = false;
    bf16_t* WBR; size_t layer_stride;
    __device__ __forceinline__ void operator()(const f32x4 (&acc)[2][2][4][2], const Unit& u, int wr, int wc, int fr, int fq) const {
        const int lg = u.pn, l = lg >> 2, g = lg & 3, ob = (u.pm & 7) * BM;
        bf16_t* base = WBR + (size_t)l * layer_stride + g * 256 + wc * 32 + 8 * fq;
#pragma unroll
        for (int ai = 0; ai < 2; ++ai)
#pragma unroll
            for (int m = 0; m < 4; ++m) { const int o = ob + ai * HALF + wr * 64 + m * 16 + fr;
#pragma unroll
                for (int bj = 0; bj < 2; ++bj) *(u32x4*)(base + (size_t)o * 1024 + bj * HALF) = pack8(acc[ai][bj][m][0], acc[ai][bj][m][1]); }
    }
};
struct FoldOrder {
    int c;
    __device__ bool next(int i, Unit& u) const { if (i > 0 || c >= 128) return false; u.pm = c; u.pn = c >> 3; return true; }
    __device__ __forceinline__ void a_ready(const Unit&) const {}
    __device__ __forceinline__ void done(const Unit&) const {}
};

template <class Epi, class Sched, bool ALIGN_EPI = false, bool SP2 = false, bool HALF_M = false>
__device__ __forceinline__ void gemm_phase(PG8_LAS unsigned char* lds, const Gemm g, const Sched& S, const Epi& E) {
    int tid_ = threadIdx.x; asm volatile("" : "+v"(tid_));
    const int tid = tid_, wid = __builtin_amdgcn_readfirstlane(tid >> 6), lane = tid & 63, wr = wid >> 2, wc = wid & 3, fr = lane & 15, fq = lane >> 4;
    const int K = g.K, nt = K / BK;
    unsigned voffA[2], voffB[2];
#pragma unroll
    for (int i = 0; i < 2; ++i) { int R, C; stage_rc(tid * 16 + i * 8192, R, C); const int Rb = Epi::PERM ? ((R & ~31) + perm32(R & 31)) : R;
        voffA[i] = (unsigned)(R * K + C) * 2u; voffB[i] = (unsigned)(Rb * K + C) * 2u; }
    const size_t kstep = (size_t)(BK * 2);
    const size_t hstep = (size_t)HALF * K * 2;
    const size_t tstep = 2 * hstep;
    const unsigned ldsw = (unsigned)wid * 1024u;
    const int aoff = lds_byte(wr * 64 + fr, fq * 8), boff = lds_byte(wc * 32 + fr, fq * 8);
#define PG8_SA(b, h) (((b) * 2 + (h)) * HTB)
#define PG8_SB(b, h) ((4 + (b) * 2 + (h)) * HTB)
#define PG8_STAGE(bufoff, gbase, voff) do { _Pragma("unroll") for (int _i = 0; _i < 2; ++_i) \
        __builtin_amdgcn_global_load_lds((const unsigned*)((const char*)(gbase) + (voff)[_i]), (PG8_LAS unsigned*)(lds + (bufoff) + ldsw + _i * 8192), 16, 0, 0); } while (0)
#define PG8_LDA(dst, b, h) do { _Pragma("unroll") for (int m = 0; m < 4; ++m) _Pragma("unroll") for (int k = 0; k < 2; ++k) dst[m][k] = *(const PG8_LAS bf16x8*)(lds + PG8_SA(b, h) + aoff + m * 2048 + k * 1024); } while (0)
#define PG8_LDB(dst, b, h) do { _Pragma("unroll") for (int n = 0; n < 2; ++n) _Pragma("unroll") for (int k = 0; k < 2; ++k) dst[n][k] = *(const PG8_LAS bf16x8*)(lds + PG8_SB(b, h) + boff + n * 2048 + k * 1024); } while (0)
#define PG8_MMA(ai, bj, At, Bt) do { __builtin_amdgcn_s_setprio(1); _Pragma("unroll") for (int m = 0; m < 4; ++m) _Pragma("unroll") for (int n = 0; n < 2; ++n) _Pragma("unroll") for (int k = 0; k < 2; ++k) \
        acc[ai][bj][m][n] = __builtin_amdgcn_mfma_f32_16x16x32_bf16(Bt[n][k], At[m][k], acc[ai][bj][m][n], 0, 0, 0); __builtin_amdgcn_s_setprio(0); } while (0)
#define PG8_WAIT_V(n) asm volatile("s_waitcnt vmcnt(" #n ")" ::: "memory")
#define PG8_WAIT_L(n) asm volatile("s_waitcnt lgkmcnt(" #n ")" ::: "memory")
#define PG8_BAR __builtin_amdgcn_s_barrier()
#define PG8_SCHED __builtin_amdgcn_sched_barrier(0)
    Unit cur, nxt; int ui = 0;
    if (!S.next(0, cur)) return;
    f32x4 acc[2][2][4][2];
#pragma unroll
    for (int a = 0; a < 2; ++a)
#pragma unroll
        for (int b = 0; b < 2; ++b)
#pragma unroll
            for (int m = 0; m < 4; ++m)
#pragma unroll
                for (int n = 0; n < 2; ++n) acc[a][b][m][n] = (f32x4){0.f, 0.f, 0.f, 0.f};
    bf16x8 At[4][2], B0[2][2], B1[2][2];
    const size_t mstep = HALF_M ? hstep : tstep;
    const char* cA = (const char*)g.A + (size_t)cur.pm * mstep; const char* cB = (const char*)g.Bt + (size_t)cur.pn * tstep;
    S.a_ready(cur);
    if constexpr (SP2) {
        PG8_STAGE(PG8_SB(0, 0), cB, voffB); PG8_STAGE(PG8_SB(0, 1), cB + hstep, voffB); PG8_STAGE(PG8_SA(0, 0), cA, voffA); if constexpr (!HALF_M) PG8_STAGE(PG8_SA(0, 1), cA + hstep, voffA);
        if (wr == 1) PG8_BAR;
        if constexpr (HALF_M) PG8_WAIT_V(0); else PG8_WAIT_V(2);
        PG8_BAR;
        PG8_STAGE(PG8_SB(1, 0), cB + kstep, voffB); PG8_STAGE(PG8_SA(1, 0), cA + kstep, voffA); PG8_STAGE(PG8_SB(1, 1), cB + hstep + kstep, voffB);
        PG8_WAIT_V(6); PG8_BAR;
    } else {
        PG8_STAGE(PG8_SB(0, 0), cB, voffB); PG8_STAGE(PG8_SA(0, 0), cA, voffA); PG8_STAGE(PG8_SB(0, 1), cB + hstep, voffB); PG8_STAGE(PG8_SA(0, 1), cA + hstep, voffA);
        if (wr == 1) PG8_BAR;
        PG8_WAIT_V(4); PG8_BAR;
        PG8_STAGE(PG8_SB(1, 0), cB + kstep, voffB); PG8_STAGE(PG8_SA(1, 0), cA + kstep, voffA); PG8_STAGE(PG8_SB(1, 1), cB + hstep + kstep, voffB);
        PG8_WAIT_V(6); PG8_BAR;
    }
    for (;;) {
        const bool has_next = S.next(ui + 1, nxt);
        const char* nA = has_next ? (const char*)g.A + (size_t)nxt.pm * mstep : cA; const char* nB = has_next ? (const char*)g.Bt + (size_t)nxt.pn * tstep : cB;
        for (int t = 0; t < nt; t += 2) {
            const bool last = (t == nt - 2);
            const char* a1 = cA + (size_t)(t + 1) * kstep;
            const char* a2 = last ? nA : cA + (size_t)(t + 2) * kstep; const char* b2 = last ? nB : cB + (size_t)(t + 2) * kstep;
            const char* a3 = a2 + kstep; const char* b3 = b2 + kstep;
            if (last && has_next) S.a_ready(nxt);
            if constexpr (SP2) {
            if constexpr (!HALF_M) {
            PG8_LDB(B0, 0, 0); PG8_LDB(B1, 0, 1); PG8_SCHED; PG8_LDA(At, 0, 0); PG8_STAGE(PG8_SA(1, 1), a1 + hstep, voffA);
            PG8_WAIT_V(8); PG8_WAIT_L(0); PG8_BAR; PG8_MMA(0, 0, At, B0); PG8_MMA(0, 1, At, B1); PG8_BAR; PG8_SCHED;
            PG8_LDA(At, 0, 1); PG8_STAGE(PG8_SB(0, 0), b2, voffB); PG8_STAGE(PG8_SB(0, 1), b2 + hstep, voffB); PG8_STAGE(PG8_SA(0, 0), a2, voffA);
            PG8_WAIT_V(8); PG8_WAIT_L(0); PG8_BAR; PG8_MMA(1, 0, At, B0); PG8_MMA(1, 1, At, B1); PG8_BAR; PG8_SCHED;
            PG8_LDB(B0, 1, 0); PG8_LDB(B1, 1, 1); PG8_SCHED; PG8_LDA(At, 1, 0); PG8_STAGE(PG8_SA(0, 1), a2 + hstep, voffA);
            PG8_WAIT_V(8); PG8_WAIT_L(0); PG8_BAR; PG8_MMA(0, 0, At, B0); PG8_MMA(0, 1, At, B1); PG8_BAR; PG8_SCHED;
            PG8_LDA(At, 1, 1); PG8_STAGE(PG8_SB(1, 0), b3, voffB); PG8_STAGE(PG8_SB(1, 1), b3 + hstep, voffB); PG8_STAGE(PG8_SA(1, 0), a3, voffA);
            PG8_WAIT_V(8); PG8_WAIT_L(0); PG8_BAR; PG8_MMA(1, 0, At, B0); PG8_MMA(1, 1, At, B1); PG8_BAR; PG8_SCHED;
            } else {
            (void)a1;
            PG8_LDB(B0, 0, 0); PG8_LDB(B1, 0, 1); PG8_SCHED; PG8_LDA(At, 0, 0);
            PG8_WAIT_L(0); PG8_BAR; PG8_MMA(0, 0, At, B0); PG8_MMA(0, 1, At, B1); PG8_BAR; PG8_SCHED;
            PG8_STAGE(PG8_SB(0, 0), b2, voffB); PG8_STAGE(PG8_SB(0, 1), b2 + hstep, voffB); PG8_STAGE(PG8_SA(0, 0), a2, voffA);
            PG8_WAIT_V(6); PG8_BAR; PG8_BAR; PG8_SCHED;
            PG8_LDB(B0, 1, 0); PG8_LDB(B1, 1, 1); PG8_SCHED; PG8_LDA(At, 1, 0);
            PG8_WAIT_L(0); PG8_BAR; PG8_MMA(0, 0, At, B0); PG8_MMA(0, 1, At, B1); PG8_BAR; PG8_SCHED;
            PG8_STAGE(PG8_SB(1, 0), b3, voffB); PG8_STAGE(PG8_SB(1, 1), b3 + hstep, voffB); PG8_STAGE(PG8_SA(1, 0), a3, voffA);
            PG8_WAIT_V(6); PG8_BAR; PG8_BAR; PG8_SCHED;
            }
            } else {
            PG8_LDB(B0, 0, 0); PG8_SCHED; PG8_LDA(At, 0, 0); PG8_STAGE(PG8_SA(1, 1), a1 + hstep, voffA);
            PG8_WAIT_L(8); PG8_BAR; PG8_WAIT_L(0); PG8_MMA(0, 0, At, B0); PG8_BAR; PG8_SCHED;
            PG8_LDB(B1, 0, 1); PG8_STAGE(PG8_SB(0, 0), b2, voffB);
            PG8_BAR; PG8_WAIT_L(0); PG8_MMA(0, 1, At, B1); PG8_BAR;
            PG8_LDA(At, 0, 1); PG8_STAGE(PG8_SA(0, 0), a2, voffA);
            PG8_BAR; PG8_WAIT_L(0); PG8_MMA(1, 0, At, B0); PG8_BAR; PG8_SCHED;
            PG8_STAGE(PG8_SB(0, 1), b2 + hstep, voffB);
            PG8_WAIT_V(6); PG8_BAR; PG8_MMA(1, 1, At, B1); PG8_BAR;
            PG8_LDB(B0, 1, 0); PG8_SCHED; PG8_LDA(At, 1, 0); PG8_STAGE(PG8_SA(0, 1), a2 + hstep, voffA);
            PG8_WAIT_L(8); PG8_BAR; PG8_WAIT_L(0); PG8_MMA(0, 0, At, B0); PG8_BAR; PG8_SCHED;
            PG8_LDB(B1, 1, 1); PG8_STAGE(PG8_SB(1, 0), b3, voffB);
            PG8_BAR; PG8_WAIT_L(0); PG8_MMA(0, 1, At, B1); PG8_BAR;
            PG8_LDA(At, 1, 1); PG8_STAGE(PG8_SA(1, 0), a3, voffA);
            PG8_BAR; PG8_WAIT_L(0); PG8_MMA(1, 0, At, B0); PG8_BAR; PG8_SCHED;
            PG8_STAGE(PG8_SB(1, 1), b3 + hstep, voffB);
            PG8_WAIT_V(6); PG8_BAR; PG8_MMA(1, 1, At, B1); PG8_BAR;
            }
        }
        if constexpr (ALIGN_EPI) { if (wr == 0) PG8_BAR; }
        if constexpr (!Epi::AFTER_DRAIN) { E(acc, cur, wr, wc, fr, fq); S.done(cur); }
        if (!has_next) break;
        if constexpr (!Epi::KEEP_ACC) {
#pragma unroll
        for (int a = 0; a < 2; ++a)
#pragma unroll
            for (int b = 0; b < 2; ++b)
#pragma unroll
                for (int m = 0; m < 4; ++m)
#pragma unroll
                    for (int n = 0; n < 2; ++n) acc[a][b][m][n] = (f32x4){0.f, 0.f, 0.f, 0.f};
        }
        cur = nxt; cA = nA; cB = nB; ++ui;
        if constexpr (ALIGN_EPI) { if (wr == 1) PG8_BAR; }
    }
    PG8_WAIT_V(0);
    if constexpr (!ALIGN_EPI) { if (wr == 0) PG8_BAR; }
    PG8_BAR;
    if constexpr (Epi::AFTER_DRAIN) { E.fused(acc, cur, wr, wc, fr, fq, lds, wid, lane); S.done(cur); }
#undef PG8_SA
#undef PG8_SB
#undef PG8_STAGE
#undef PG8_LDA
#undef PG8_LDB
#undef PG8_MMA
#undef PG8_WAIT_V
#undef PG8_WAIT_L
#undef PG8_BAR
#undef PG8_SCHED
}
}

constexpr int NWAVES = 8;
constexpr int BATCH = 4, SEQ = 2048, D = 2048, DEPTH = 4, M = BATCH * SEQ;
constexpr int DFF = 5632, NH = 8, HD = 128, WIDE = 1024;
constexpr int IN_W = 14344, WIN_N = 14336;
constexpr int SRC_FQ = 1024, SRC_FLOGIT = 4096, SRC_RQ = 4104, SRC_RK = 5128, SRC_RV = 6152, SRC_RG = 7176, SRC_GATES = 8200;
#ifndef MK_PER_PHASE
#define MK_PER_PHASE 0
#endif
constexpr int N_PHASES = 2 + 8 * 2 + 4 * 4 + 1;

constexpr size_t MiB = 1u << 20;
constexpr size_t WS_CTL = 0, CTL_ZERO_BYTES = 1 * MiB;
constexpr size_t WS_WF = 1 * MiB;
constexpr size_t WS_COS = 2 * MiB, WS_SIN = 2 * MiB + 512 * 1024;
constexpr size_t WS_SS = 3 * MiB;
constexpr size_t WS_FL = 3 * MiB + 512 * 1024;
constexpr size_t WS_WP = 4 * MiB;
constexpr size_t WS_WBPT = 6 * MiB;
constexpr size_t WS_W13T = 32 * MiB,  SZ_W13T = (size_t)2 * DFF * D * 2;
constexpr size_t WS_W2T = WS_W13T + 8 * SZ_W13T, SZ_W2T = (size_t)D * DFF * 2;
constexpr size_t WS_WINT = WS_W2T + 8 * SZ_W2T, SZ_WINT = (size_t)WIN_N * D * 2;
constexpr size_t WS_WBR = WS_WINT + 4 * SZ_WINT, SZ_WBR = (size_t)3 * D * WIDE * 2;
constexpr size_t WS_WOUT = WS_WBR + 4 * SZ_WBR, SZ_WOUT = (size_t)D * D * 2;
constexpr size_t WS_X = WS_WOUT + 4 * SZ_WOUT;
constexpr size_t WS_XB = WS_X + (size_t)M * D * 4;
constexpr size_t WS_H = WS_XB + (size_t)M * D * 2;
constexpr size_t SZ_ACT = (size_t)M * WIDE * 2;
constexpr size_t WS_U = WS_H + (size_t)M * DFF * 2;
constexpr size_t WS_FQ = WS_U + SZ_ACT, WS_FK = WS_FQ + SZ_ACT, WS_FV = WS_FK + SZ_ACT, WS_RQ = WS_FV + SZ_ACT, WS_RK = WS_RQ + SZ_ACT, WS_RV = WS_RK + SZ_ACT, WS_RG = WS_RV + SZ_ACT;
constexpr size_t WS_GATES = WS_RG + SZ_ACT;
constexpr size_t WS_BRA = WS_GATES + (size_t)M * 6144 * 2;
constexpr size_t WS_MG = WS_BRA + 3 * SZ_ACT;
constexpr size_t WS_MGB = WS_MG + (size_t)M * D * 4;
constexpr size_t WS_END = WS_MGB + (size_t)M * D * 2;
static_assert(WS_W13T % 256 == 0 && SZ_W13T % 256 == 0 && SZ_W2T % 256 == 0 && SZ_WINT % 256 == 0 && WS_X % 256 == 0 && WS_END < (size_t)1700 * MiB, "d_ws map");
constexpr int CW_TMO = 0, CW_CODE = 1;
constexpr int CW_QUEUE = 64;
constexpr int CW_BAR = 4096;
constexpr int RING_OFF = 0, RING_BYTES = 131072;
constexpr int LDSCTL_OFF = RING_BYTES, MISC_OFF = LDSCTL_OFF + 320;
constexpr int LDS_BYTES = 147456;
static_assert(MISC_OFF + 128 <= LDS_BYTES, "LDS map");

#define GAS __attribute__((address_space(1)))
#define LAS __attribute__((address_space(3)))
typedef unsigned short bf16;
typedef unsigned v4u __attribute__((ext_vector_type(4)));
typedef unsigned v2u __attribute__((ext_vector_type(2)));
typedef float f32x4 __attribute__((ext_vector_type(4)));
typedef float f32x16 __attribute__((ext_vector_type(16)));
typedef short bf16x8 __attribute__((ext_vector_type(8)));
typedef short s16x4 __attribute__((ext_vector_type(4)));
typedef GAS unsigned gu32;
#define RLX_AGENT __ATOMIC_RELAXED, __HIP_MEMORY_SCOPE_AGENT
#define LDS_WAIT() asm volatile("s_waitcnt lgkmcnt(0)" ::: "memory")
#define VM_WAIT() asm volatile("s_waitcnt vmcnt(0)" ::: "memory")
__device__ __forceinline__ unsigned f2bf(float f) { unsigned u = __builtin_bit_cast(unsigned, f); return (u + 0x7fffu + ((u >> 16) & 1u)) >> 16; }
__device__ __forceinline__ unsigned pk2(float lo, float hi) { return f2bf(lo) | (f2bf(hi) << 16); }
__device__ __forceinline__ float bf2f(unsigned short h) { return __uint_as_float((unsigned)h << 16); }

#define XB_TMO      128
#define XB_XCNT(j)  (256  + 64 * (j))
#define XB_XSUB(j)  (1280 + 64 * (j))
#define XB_XGEN(j)  (2304 + 64 * (j))
#define XB_TOP      3328
#define XB_TOPGEN   3392
#define XCD_BAR_WORDS 3456
#define XB_SPIN_CAP (1u << 18)

__device__ __forceinline__ unsigned xb_ld(unsigned* p)              { return __hip_atomic_load(p, __ATOMIC_RELAXED, __HIP_MEMORY_SCOPE_AGENT); }
__device__ __forceinline__ unsigned xb_add(unsigned* p, unsigned v) { return __hip_atomic_fetch_add(p, v, __ATOMIC_RELAXED, __HIP_MEMORY_SCOPE_AGENT); }
__device__ __forceinline__ unsigned xb_xcc_id() { return (unsigned)__builtin_amdgcn_s_getreg((3 << 11) | 20) & 0xFu; }
#define XB_SPIN(cond, bar) do { unsigned _sp = 0; while (cond) { __builtin_amdgcn_s_sleep(1); \
    if ((++_sp & 255u) == 0u) { if (xb_ld(&(bar)[XB_TMO])) break; if (_sp > XB_SPIN_CAP) { atomicAdd(&(bar)[XB_TMO], 1u); break; } } } } while (0)

struct XcdBarrier {
    unsigned* bar; unsigned x;
    volatile LAS unsigned* st;
};

__device__ __forceinline__ XcdBarrier xcd_barrier_post(unsigned* bar, volatile LAS unsigned* st) {
    XcdBarrier b; b.bar = bar; b.x = xb_xcc_id(); b.st = st;
    if (threadIdx.x == 0) (void)xb_add(&bar[XB_XCNT(b.x)], 1u);
    return b;
}
__device__ __forceinline__ void xcd_barrier_complete(unsigned* bar, unsigned x, unsigned& nloc, unsigned& nx) {
    const unsigned G = gridDim.x * gridDim.y * gridDim.z;
    unsigned sum, cnt, mine, sp = 0u;
    for (;;) {
        sum = 0u; cnt = 0u; mine = 0u;
#pragma unroll
        for (unsigned j = 0; j < 16; ++j) { const unsigned c = xb_ld(&bar[XB_XCNT(j)]); sum += c; cnt += (c > 0u) ? 1u : 0u; mine = (j == x) ? c : mine; }
        if (sum == G) break;
        __builtin_amdgcn_s_sleep(1);
        if ((++sp & 255u) == 0u) { if (xb_ld(&bar[XB_TMO])) break; if (sp > XB_SPIN_CAP) { atomicAdd(&bar[XB_TMO], 1u); break; } }
    }
    nloc = mine > 0u ? mine : 1u; nx = cnt > 0u ? cnt : 1u;
}

__device__ __forceinline__ void xcd_barrier(const XcdBarrier& b) {
    asm volatile("s_waitcnt vmcnt(0)" ::: "memory");
    __syncthreads();
    if (threadIdx.x == 0) {
        unsigned* bar = b.bar;
        __builtin_amdgcn_s_waitcnt(0);
        unsigned nloc = b.st[0], nx = b.st[1];
        if (nloc == 0u) { xcd_barrier_complete(bar, b.x, nloc, nx); b.st[0] = nloc; b.st[1] = nx; }
        const unsigned old = xb_add(&bar[XB_XSUB(b.x)], 1u);
        const unsigned gen = old / nloc;
        if (old + 1u == (gen + 1u) * nloc) {
            __builtin_amdgcn_fence(__ATOMIC_RELEASE, "agent");
            asm volatile("s_waitcnt vmcnt(0)" ::: "memory");
            const unsigned og = xb_add(&bar[XB_TOP], 1u);
            const unsigned tg = og / nx;
            if (og + 1u == (tg + 1u) * nx) xb_add(&bar[XB_TOPGEN], 1u);
            else XB_SPIN(xb_ld(&bar[XB_TOPGEN]) == tg, bar);
            __builtin_amdgcn_fence(__ATOMIC_ACQUIRE, "agent");
            xb_add(&bar[XB_XGEN(b.x)], 1u);
            asm volatile("s_waitcnt vmcnt(0)" ::: "memory");
        } else {
            XB_SPIN(xb_ld(&bar[XB_XGEN(b.x)]) == gen, bar);
            __builtin_amdgcn_fence(__ATOMIC_ACQUIRE, "agent");
            asm volatile("s_waitcnt vmcnt(0)" ::: "memory");
        }
    }
    __syncthreads();
}

struct Args {
    const float* in[17];
    float* out; unsigned char* ws;
    int ph_lo, ph_hi, li, pad;
};
enum { I_X = 0, I_F1N, I_F1W13, I_F1W2, I_MIXN, I_WIN, I_FB, I_POOLW, I_POOLS, I_WBP, I_WBF, I_WBRT, I_WOUT, I_F2N, I_F2W13, I_F2W2, I_FINN };

__device__ __forceinline__ float wave_sum(float v) {
#pragma unroll
    for (int o = 1; o < 64; o <<= 1) v += __shfl_xor(v, o);
    return v;
}

struct TrItem { const float* p; const float* gain; bf16* dst0; size_t ldsrc, ldd; };
__device__ __forceinline__ void tr_load(const TrItem& t, float (&va)[32], float (&vb)[32], float& gv, int lane) {
#pragma unroll
    for (int i = 0; i < 32; ++i) { va[i] = t.p[(size_t)(2 * i) * t.ldsrc]; vb[i] = t.p[(size_t)(2 * i) * t.ldsrc + 32]; }
    gv = t.gain ? t.gain[lane] : 1.0f;
}
__device__ __forceinline__ void tr_store(const TrItem& t, const float (&va)[32], const float (&vb)[32], float gv, LAS float* scr, int lane) {
    const int c = lane & 7;
#pragma unroll
    for (int hh = 0; hh < 2; ++hh) {
#pragma unroll
        for (int i = 0; i < 32; ++i) { const float g0 = __builtin_bit_cast(float, __builtin_amdgcn_readlane(__builtin_bit_cast(int, gv), 2 * i)), g1 = __builtin_bit_cast(float, __builtin_amdgcn_readlane(__builtin_bit_cast(int, gv), 2 * i + 1));
            scr[(2 * i + (lane >> 5)) * 33 + (lane & 31)] = (hh ? vb[i] : va[i]) * ((lane >> 5) ? g1 : g0); }
        LDS_WAIT(); asm volatile("" ::: "memory");
#pragma unroll
        for (int j = 0; j < 4; ++j) { const int n = (lane >> 3) + 8 * j; const LAS float* s = scr + (8 * c) * 33 + n;
            v4u o; o.x = pg8::cvt_pk_bf16(s[0 * 33], s[1 * 33]); o.y = pg8::cvt_pk_bf16(s[2 * 33], s[3 * 33]); o.z = pg8::cvt_pk_bf16(s[4 * 33], s[5 * 33]); o.w = pg8::cvt_pk_bf16(s[6 * 33], s[7 * 33]);
            *(GAS v4u*)(t.dst0 + (size_t)(32 * hh + n) * t.ldd + 8 * c) = o; }
        LDS_WAIT(); asm volatile("" ::: "memory");
    }
}
__device__ __forceinline__ int win_src_col(int d0) {
    const int reg = d0 >> 10, w = d0 & 1023;
    if (reg < 4) return d0;
    if (reg == 4 || reg == 5) { const int pu = w >> 8, c = w & 255, head = 2 * pu + ((c & 127) >> 6), d = (c >> 7) * 64 + (c & 63); return (reg == 4 ? SRC_RQ : SRC_RK) + head * 128 + d; }
    if (reg == 6) return SRC_RV + w;
    if (reg == 7) return SRC_RG + w;
    return SRC_GATES + (d0 - 8192);
}
__device__ __forceinline__ void sincos_red(float a, float& sn, float& cs) {
    const double x = (double)a; const double q = __builtin_rint(x * 0.6366197723675814); const int n = (int)q;
    const float r = (float)(x - q * 1.5707963267948966), r2 = r * r;
    const float s = r + r * r2 * (-1.6666654611e-1f + r2 * (8.3321608736e-3f + r2 * (-1.9515295891e-4f)));
    const float c = 1.0f - 0.5f * r2 + r2 * r2 * (4.166664568298827e-2f + r2 * (-1.388731625493765e-3f + r2 * 2.443315711809948e-5f));
    switch (n & 3) { case 0: sn = s; cs = c; break; case 1: sn = c; cs = -s; break; case 2: sn = -s; cs = -c; break; default: sn = -c; cs = s; break; }
}


__device__ __forceinline__ void p0_prologue(const Args& args, LAS unsigned char* lds, int wave, int lane, int tid, int G) {
    unsigned char* ws = args.ws;
    LAS float* scr = (LAS float*)(lds + RING_OFF + wave * 16384);
    const int gw = (int)blockIdx.x * NWAVES + wave, NGW = G * NWAVES;
    constexpr int I_W13 = 32 * 176, I_W2 = 88 * 32, I_IN = 32 * 224, I_BR = 16 * 32, I_OUT = 32 * 32;
    constexpr int I_LAYER = 2 * I_W13 + 2 * I_W2 + I_IN + 3 * I_BR + I_OUT, I_ALL = DEPTH * I_LAYER;
#define TR_DECODE(it, T) do { \
        const int itr_ = I_ALL - 1 - (it); const int l = itr_ / I_LAYER; int r = itr_ % I_LAYER;     \
        const float* src; size_t ldsrc; int k0, s0; const float* gain = nullptr; bf16* dst0; size_t ldd; \
        if (r < 2 * I_W13) { \
            const int f = r / I_W13; r %= I_W13; const int kb = r / 176, db = r % 176, d0 = 64 * db, pn = d0 >> 8, w = d0 & 255; \
            src = (f ? args.in[I_F2W13] : args.in[I_F1W13]) + (size_t)l * D * 2 * DFF; ldsrc = 2 * DFF; k0 = 64 * kb; s0 = (w >> 7) * DFF + pn * 128 + (w & 127); \
            gain = (f ? args.in[I_F2N] : args.in[I_F1N]) + l * D; dst0 = (bf16*)(ws + WS_W13T + (size_t)(2 * l + f) * SZ_W13T) + (size_t)d0 * D + k0; ldd = D; \
        } else if ((r -= 2 * I_W13) < 2 * I_W2) { \
            const int f = r / I_W2; r %= I_W2; const int kb = r / 32, db = r % 32; \
            src = (f ? args.in[I_F2W2] : args.in[I_F1W2]) + (size_t)l * DFF * D; ldsrc = D; k0 = 64 * kb; s0 = 64 * db; \
            dst0 = (bf16*)(ws + WS_W2T + (size_t)(2 * l + f) * SZ_W2T) + (size_t)s0 * DFF + k0; ldd = DFF; \
        } else if ((r -= 2 * I_W2) < I_IN) { \
            const int kb = r / 224, db = r % 224, d0 = 64 * db; \
            src = args.in[I_WIN] + (size_t)l * D * IN_W; ldsrc = IN_W; k0 = 64 * kb; s0 = win_src_col(d0); gain = args.in[I_MIXN] + l * D; \
            dst0 = (bf16*)(ws + WS_WINT + (size_t)l * SZ_WINT) + (size_t)d0 * D + k0; ldd = D; \
        } else if ((r -= I_IN) < 3 * I_BR) { \
            const int br = r / I_BR; r %= I_BR; const int kb = r / 32, db = r % 32; k0 = 64 * kb; s0 = 64 * db; ldsrc = D; \
            src = (br == 0 ? args.in[I_WBP] : br == 1 ? args.in[I_WBF] : args.in[I_WBRT]) + (size_t)l * WIDE * D; \
            if (br == 0) { gain = args.in[I_POOLS] + l * WIDE; \
                dst0 = (bf16*)(ws + WS_WBPT) + ((size_t)(l * 4 + (k0 >> 8)) * D + s0) * 256 + (k0 & 255); ldd = 256; } \
            else { dst0 = (bf16*)(ws + WS_WBR + (size_t)l * SZ_WBR) + (size_t)br * D * WIDE + (size_t)s0 * WIDE + k0; ldd = WIDE; } \
        } else { r -= 3 * I_BR; \
            const int kb = r / 32, db = r % 32; k0 = 64 * kb; s0 = 64 * db; ldsrc = D; \
            src = args.in[I_WOUT] + (size_t)l * D * D; dst0 = (bf16*)(ws + WS_WOUT + (size_t)l * SZ_WOUT) + (size_t)s0 * D + k0; ldd = D; \
        } \
        (T).p = src + (size_t)(k0 + (lane >> 5)) * ldsrc + s0 + (lane & 31); (T).gain = gain ? gain + k0 : nullptr; (T).dst0 = dst0; (T).ldsrc = ldsrc; (T).ldd = ldd; } while (0)
    {
        float vaA[32], vbA[32], vaB[32], vbB[32]; float gvA = 1.f, gvB = 1.f; TrItem tA, tB;
        int it = gw;
        if (it < I_ALL) { TR_DECODE(it, tA); tr_load(tA, vaA, vbA, gvA, lane); }
        for (; it < I_ALL; it += 2 * NGW) {
            const bool hasB = it + NGW < I_ALL, hasA2 = it + 2 * NGW < I_ALL;
            if (hasB) { TR_DECODE(it + NGW, tB); tr_load(tB, vaB, vbB, gvB, lane); }
            tr_store(tA, vaA, vbA, gvA, scr, lane);
            if (hasA2) { TR_DECODE(it + 2 * NGW, tA); tr_load(tA, vaA, vbA, gvA, lane); }
            if (hasB) tr_store(tB, vaB, vbB, gvB, scr, lane);
        }
    }
#undef TR_DECODE
    for (int m = gw; m < M; m += NGW) {
        const GAS f32x4* xr = (const GAS f32x4*)(args.in[I_X] + (size_t)m * D) + lane;
        GAS v2u* o8 = (GAS v2u*)((bf16*)(ws + WS_XB) + (size_t)m * D) + lane; float s = 0.f;
#pragma unroll
        for (int j = 0; j < 8; ++j) { const f32x4 v = xr[64 * j]; s += (v.x * v.x + v.y * v.y) + (v.z * v.z + v.w * v.w); v2u w; w.x = pk2(v.x, v.y); w.y = pk2(v.z, v.w); o8[64 * j] = w; }
        s = wave_sum(s);
        if (lane < 8) ((float*)(ws + WS_SS))[(size_t)m * 8 + lane] = lane == 0 ? s : 0.f;
    }
    const int gt = (int)blockIdx.x * (NWAVES * 64) + tid, NGT = G * NWAVES * 64;
    for (int i = gt; i < SEQ * 64; i += NGT) {
        const int t = i >> 6, j = i & 63; const float inv = powf(10000.0f, -(float)j / 64.0f); float sn, cs; sincos_red((float)t * inv, sn, cs);
        ((float*)(ws + WS_COS))[i] = cs; ((float*)(ws + WS_SIN))[i] = sn; }
    for (int i = gt; i < DEPTH * 4 * 256 * 256; i += NGT) ((bf16*)(ws + WS_WP))[i] = (bf16)f2bf(args.in[I_POOLW][i]);
    for (int i = gt; i < DEPTH * 8 * D; i += NGT) {
        const int l = i / (8 * D), h = (i / D) & 7, k = i % D;
        ((float*)(ws + WS_WF))[i] = args.in[I_WIN][(size_t)l * D * IN_W + (size_t)k * IN_W + SRC_FLOGIT + h] * args.in[I_MIXN][l * D + k]; }
}

__device__ __forceinline__ void flogit_rows(unsigned char* ws, int l, int wave, int lane) {
    const bf16* XBp = (const bf16*)(ws + WS_XB); const float* WF = (const float*)(ws + WS_WF) + (size_t)l * 8 * D; const float* ss = (const float*)(ws + WS_SS); float* FL = (float*)(ws + WS_FL);
    const int row0 = (int)blockIdx.x * 32 + wave * 4;
    float acc[4][8];
#pragma unroll
    for (int r = 0; r < 4; ++r)
#pragma unroll
        for (int h = 0; h < 8; ++h) acc[r][h] = 0.f;
#pragma unroll 2
    for (int j = 0; j < 8; ++j) {
        f32x4 wv[8], xv[4];
#pragma unroll
        for (int h = 0; h < 8; ++h) wv[h] = *(const f32x4*)(WF + h * D + 256 * j + 4 * lane);
#pragma unroll
        for (int r = 0; r < 4; ++r) { const v2u w = *(const GAS v2u*)(XBp + (size_t)(row0 + r) * D + 256 * j + 4 * lane);
            xv[r] = (f32x4){__uint_as_float(w.x << 16), __uint_as_float(w.x & 0xffff0000u), __uint_as_float(w.y << 16), __uint_as_float(w.y & 0xffff0000u)}; }
#pragma unroll
        for (int r = 0; r < 4; ++r)
#pragma unroll
            for (int h = 0; h < 8; ++h) acc[r][h] += (xv[r].x * wv[h].x + xv[r].y * wv[h].y) + (xv[r].z * wv[h].z + xv[r].w * wv[h].w);
    }
#pragma unroll
    for (int r = 0; r < 4; ++r) { const float rs = pg8::row_rstd(ss, row0 + r);
#pragma unroll
        for (int h = 0; h < 8; ++h) { const float s = wave_sum(acc[r][h]); if (lane == h) FL[(size_t)(row0 + r) * 8 + h] = s * rs; } }
}

__device__ __forceinline__ unsigned off_a(unsigned row, unsigned ch) { return 2048u * (row >> 3) + 512u * (ch >> 2) + 64u * (row & 7u) + 16u * ((ch & 3u) ^ ((row >> 2) & 3u)); }
typedef short v4i16_t __attribute__((ext_vector_type(4)));
__device__ __forceinline__ s16x4 vtr(const LAS unsigned char* p) { return __builtin_bit_cast(s16x4, __builtin_amdgcn_ds_read_tr16_b64_v4i16((LAS v4i16_t*)p)); }
__device__ __forceinline__ int crow(int r, int hi) { return (r & 3) + 8 * (r >> 2) + 4 * hi; }
constexpr int AT_HALF = 65536, AT_K0 = 0, AT_V0 = 32768;
constexpr int AT_NLB = LDSCTL_OFF + 1024, AT_WTOT = AT_NLB + 8192;
static_assert(AT_WTOT + 64 <= LDS_BYTES, "mixer LDS map");
constexpr float LOG2E_F = 1.4426950408889634f;

__device__ __forceinline__ void mix_nlb(unsigned char* ws, const float* fbias_l, LAS unsigned char* lds, int b, int h, int wave, int lane, int tid) {
    LAS float* nlb = (LAS float*)(lds + AT_NLB);
    __syncthreads();
    {
        const float* FL = (const float*)(ws + WS_FL) + (size_t)b * SEQ * 8 + h; const float fb = fbias_l[h];
        float v[4]; float s = 0.f;
#pragma unroll
        for (int e = 0; e < 4; ++e) { const float z = FL[(size_t)(4 * tid + e) * 8] + fb; v[e] = (fminf(z, 0.f) - log1pf(expf(-fabsf(z)))) * LOG2E_F; s += v[e]; }
        float sc = s;
#pragma unroll
        for (int o = 1; o < 64; o <<= 1) { const float t = __shfl_up(sc, o); if (lane >= o) sc += t; }
        LAS float* wtot = (LAS float*)(lds + AT_WTOT);
        if (lane == 63) wtot[wave] = sc;
        __syncthreads();
        float pre = 0.f;
        for (int w = 0; w < wave; ++w) pre += wtot[w];
        float run = pre + (sc - s);
#pragma unroll
        for (int e = 0; e < 4; ++e) { run += v[e]; nlb[4 * tid + e] = -run; }
    }
}
template <int MODE>
__device__ __forceinline__ void mix_half(unsigned char* ws, LAS unsigned char* lds_all, int b, int h, int qb, int wave, int lane) {
    LAS unsigned char* lds = lds_all + MODE * AT_HALF;
    const LAS float* nlb = (const LAS float*)(lds_all + AT_NLB);
    const int q = lane & 31, hi = lane >> 5;
    const int R0 = 128 * qb + 32 * wave, tq = R0 + q;
    const size_t rowbase = (size_t)b * SEQ;
    const bf16* Qg = (const bf16*)(ws + (MODE ? WS_RQ : WS_FQ)) + (rowbase + tq) * WIDE + h * HD;
    const bf16* Kg = (const bf16*)(ws + (MODE ? WS_RK : WS_FK)) + rowbase * WIDE + h * HD;
    const bf16* Vg = (const bf16*)(ws + (MODE ? WS_RV : WS_FV)) + rowbase * WIDE + h * HD;
    const int nt = 2 * (qb + 1);
    bf16x8 qf[8];
#pragma unroll
    for (int s = 0; s < 8; ++s) qf[s] = *(const bf16x8*)(Qg + 16 * s + 8 * hi);
    f32x16 o[4];
#pragma unroll
    for (int c = 0; c < 4; ++c)
#pragma unroll
        for (int r = 0; r < 16; ++r) o[c][r] = 0.f;
    float mrun = -1e30f, lrun = 0.f;
    unsigned stoff0;
    { const unsigned p = (unsigned)(wave * 64 + lane), row = ((p >> 7) << 3) | ((p >> 2) & 7u), ch = (((p >> 5) & 3u) << 2) | ((p & 3u) ^ ((row >> 2) & 3u)); stoff0 = row * WIDE + ch * 8u; }
#define AT_STAGE(jt, buf) do { _Pragma("unroll") for (int _i = 0; _i < 4; ++_i) { \
        __builtin_amdgcn_global_load_lds((const unsigned*)(Kg + (size_t)(64 * (jt) + 16 * _i) * WIDE + stoff0), (LAS unsigned*)(lds + AT_K0 + (buf) * 16384 + (4 * _i + wave) * 1024), 16, 0, 0); \
        __builtin_amdgcn_global_load_lds((const unsigned*)(Vg + (size_t)(64 * (jt) + 16 * _i) * WIDE + stoff0), (LAS unsigned*)(lds + AT_V0 + (buf) * 16384 + (4 * _i + wave) * 1024), 16, 0, 0); } } while (0)
    AT_STAGE(nt - 1, 0);
    asm volatile("s_waitcnt vmcnt(0)" ::: "memory");
    __syncthreads();
    unsigned kbase[2], vbase[2];
#pragma unroll
    for (int e = 0; e < 2; ++e) { kbase[e] = 2048u * ((unsigned)q >> 3) + 64u * ((unsigned)q & 7u) + 16u * ((unsigned)(2 * e + hi) ^ (((unsigned)q >> 2) & 3u)); }
    const unsigned tq_ = (unsigned)(lane & 15) >> 2, tp = (unsigned)lane & 3u, tblk = ((unsigned)lane >> 4) & 1u;
#pragma unroll
    for (int t = 0; t < 2; ++t) vbase[t] = 64u * (4u * hi + tq_) + 16u * ((2u * tblk + (tp >> 1)) ^ ((unsigned)(2 * t + hi) & 3u)) + 8u * (tp & 1u);
    for (int j = 0; j < nt; ++j) {
        const int cur = j & 1, jt = nt - 1 - j; const bool more = (j + 1 < nt);
        if (more) AT_STAGE(jt - 1, cur ^ 1);
        const bool active = (64 * jt <= R0 + 31);
        if (active) {
            const LAS unsigned char* Kt = lds + AT_K0 + cur * 16384; const LAS unsigned char* Vt = lds + AT_V0 + cur * 16384;
            f32x16 s0, s1;
            if (MODE == 0) {
#pragma unroll
                for (int g = 0; g < 4; ++g) { const f32x4 a = *(const LAS f32x4*)(nlb + 64 * jt + 8 * g + 4 * hi), c = *(const LAS f32x4*)(nlb + 64 * jt + 32 + 8 * g + 4 * hi);
#pragma unroll
                    for (int e = 0; e < 4; ++e) { s0[4 * g + e] = a[e]; s1[4 * g + e] = c[e]; } }
            } else {
#pragma unroll
                for (int r = 0; r < 16; ++r) { s0[r] = 0.f; s1[r] = 0.f; }
            }
            {
                bf16x8 kf[16];
#pragma unroll
                for (int s = 0; s < 8; ++s) { const unsigned a = kbase[s & 1] + 512u * (unsigned)(s >> 1);
                    kf[2 * s] = *(const LAS bf16x8*)(Kt + a); kf[2 * s + 1] = *(const LAS bf16x8*)(Kt + a + 8192); }
                __builtin_amdgcn_sched_barrier(0);
#pragma unroll
                for (int s = 0; s < 8; ++s) {
                    s0 = __builtin_amdgcn_mfma_f32_32x32x16_bf16(kf[2 * s], qf[s], s0, 0, 0, 0);
                    s1 = __builtin_amdgcn_mfma_f32_32x32x16_bf16(kf[2 * s + 1], qf[s], s1, 0, 0, 0);
                }
            }
            s16x4 vv[4][2][2][2];
#pragma unroll
            for (int c = 0; c < 2; ++c)
#pragma unroll
                for (int blk = 0; blk < 2; ++blk)
#pragma unroll
                    for (int st = 0; st < 2; ++st)
#pragma unroll
                        for (int t = 0; t < 2; ++t) vv[c][blk][st][t] = vtr(Vt + vbase[t] + 2048u * (unsigned)(4 * blk + 2 * st + t) + 512u * (unsigned)c);
            __builtin_amdgcn_sched_barrier(0);
            if (64 * jt + 63 > R0) {
                const float NEG = MODE == 0 ? -__builtin_inff() : 0.f;
#pragma unroll
                for (int r = 0; r < 16; ++r) { const int key = 64 * jt + crow(r, hi); if (key > tq) s0[r] = NEG; if (key + 32 > tq) s1[r] = NEG; }
            }
            if (MODE == 0) {
                float pmax = s0[0];
#pragma unroll
                for (int r = 1; r < 16; ++r) pmax = fmaxf(pmax, s0[r]);
#pragma unroll
                for (int r = 0; r < 16; ++r) pmax = fmaxf(pmax, s1[r]);
                pmax = fmaxf(pmax, __shfl_xor(pmax, 32));
                const float mn = fmaxf(mrun, pmax);
                if (__any(mn > mrun)) {
                    const float alpha = __builtin_amdgcn_exp2f(mrun - mn); mrun = mn; lrun *= alpha;
#pragma unroll
                    for (int c = 0; c < 4; ++c)
#pragma unroll
                        for (int r = 0; r < 16; ++r) o[c][r] *= alpha;
                }
                float rs = 0.f;
#pragma unroll
                for (int r = 0; r < 16; ++r) { s0[r] = __builtin_amdgcn_exp2f(s0[r] - mrun); s1[r] = __builtin_amdgcn_exp2f(s1[r] - mrun); rs += s0[r] + s1[r]; }
                lrun += rs;
            }
            bf16x8 pf[2][2];
#pragma unroll
            for (int st = 0; st < 2; ++st) {
                v4u w0, w1;
                w0.x = pg8::cvt_pk_bf16(s0[8 * st + 0], s0[8 * st + 1]); w0.y = pg8::cvt_pk_bf16(s0[8 * st + 2], s0[8 * st + 3]); w0.z = pg8::cvt_pk_bf16(s0[8 * st + 4], s0[8 * st + 5]); w0.w = pg8::cvt_pk_bf16(s0[8 * st + 6], s0[8 * st + 7]);
                w1.x = pg8::cvt_pk_bf16(s1[8 * st + 0], s1[8 * st + 1]); w1.y = pg8::cvt_pk_bf16(s1[8 * st + 2], s1[8 * st + 3]); w1.z = pg8::cvt_pk_bf16(s1[8 * st + 4], s1[8 * st + 5]); w1.w = pg8::cvt_pk_bf16(s1[8 * st + 6], s1[8 * st + 7]);
                pf[0][st] = __builtin_bit_cast(bf16x8, w0); pf[1][st] = __builtin_bit_cast(bf16x8, w1);
            }
#pragma unroll
            for (int c = 2; c < 4; ++c)
#pragma unroll
                for (int blk = 0; blk < 2; ++blk)
#pragma unroll
                    for (int st = 0; st < 2; ++st)
#pragma unroll
                        for (int t = 0; t < 2; ++t) vv[c][blk][st][t] = vtr(Vt + vbase[t] + 2048u * (unsigned)(4 * blk + 2 * st + t) + 512u * (unsigned)c);
            __builtin_amdgcn_sched_barrier(0);
#pragma unroll
            for (int c = 0; c < 4; ++c)
#pragma unroll
                for (int blk = 0; blk < 2; ++blk)
#pragma unroll
                    for (int st = 0; st < 2; ++st) {
                        const s16x4 v0 = vv[c][blk][st][0], v1 = vv[c][blk][st][1];
                        bf16x8 vf; vf[0] = v0[0]; vf[1] = v0[1]; vf[2] = v0[2]; vf[3] = v0[3]; vf[4] = v1[0]; vf[5] = v1[1]; vf[6] = v1[2]; vf[7] = v1[3];
                        o[c] = __builtin_amdgcn_mfma_f32_32x32x16_bf16(vf, pf[blk][st], o[c], 0, 0, 0);
                    }
        }
        asm volatile("s_waitcnt vmcnt(0)" ::: "memory");
        __syncthreads();
    }
#undef AT_STAGE
    bf16* Yg = (bf16*)(ws + WS_BRA + (MODE ? 2 : 1) * SZ_ACT) + (rowbase + tq) * WIDE + h * HD;
    if (MODE == 0) {
        const float lt = lrun + __shfl_xor(lrun, 32), inv = 1.0f / lt;
#pragma unroll
        for (int c = 0; c < 4; ++c)
#pragma unroll
            for (int g = 0; g < 4; ++g) { v2u w; w.x = pg8::cvt_pk_bf16(o[c][4 * g] * inv, o[c][4 * g + 1] * inv); w.y = pg8::cvt_pk_bf16(o[c][4 * g + 2] * inv, o[c][4 * g + 3] * inv);
                *(GAS v2u*)(Yg + 32 * c + 8 * g + 4 * hi) = w; }
    } else {
        float sm = 0.f;
#pragma unroll
        for (int c = 0; c < 4; ++c)
#pragma unroll
            for (int r = 0; r < 16; ++r) sm += o[c][r];
        sm += __shfl_xor(sm, 32);
        const float mu = sm * (1.0f / 128.0f); float vs = 0.f;
#pragma unroll
        for (int c = 0; c < 4; ++c)
#pragma unroll
            for (int r = 0; r < 16; ++r) { const float d = o[c][r] - mu; vs += d * d; }
        vs += __shfl_xor(vs, 32);
        const float rstd = 1.0f / sqrtf(vs * (1.0f / 128.0f) + 1e-5f);
        const bf16* Gg = (const bf16*)(ws + WS_RG) + (rowbase + tq) * WIDE + h * HD;
#pragma unroll
        for (int c = 0; c < 4; ++c)
#pragma unroll
            for (int g = 0; g < 4; ++g) { const v2u gw = *(const GAS v2u*)(Gg + 32 * c + 8 * g + 4 * hi);
                const float g0 = __uint_as_float(gw.x << 16), g1 = __uint_as_float(gw.x & 0xffff0000u), g2 = __uint_as_float(gw.y << 16), g3 = __uint_as_float(gw.y & 0xffff0000u);
                v2u w; w.x = pg8::cvt_pk_bf16((o[c][4 * g] - mu) * rstd * g0, (o[c][4 * g + 1] - mu) * rstd * g1); w.y = pg8::cvt_pk_bf16((o[c][4 * g + 2] - mu) * rstd * g2, (o[c][4 * g + 3] - mu) * rstd * g3);
                *(GAS v2u*)(Yg + 32 * c + 8 * g + 4 * hi) = w; }
    }
}

__device__ __forceinline__ void mix_unit(unsigned char* ws, const float* fbias_l, LAS unsigned char* lds, int b, int h, int qb, int wave, int lane, int tid) {
    mix_nlb(ws, fbias_l, lds, b, h, wave, lane, tid);
    if (wave < 4) mix_half<0>(ws, lds, b, h, qb, wave, lane); else mix_half<1>(ws, lds, b, h, qb, wave - 4, lane);
}

__device__ __forceinline__ void unpack8(const v4u x, float (&f)[8]) {
    f[0] = __uint_as_float(x.x << 16); f[1] = __uint_as_float(x.x & 0xffff0000u); f[2] = __uint_as_float(x.y << 16); f[3] = __uint_as_float(x.y & 0xffff0000u);
    f[4] = __uint_as_float(x.z << 16); f[5] = __uint_as_float(x.z & 0xffff0000u); f[6] = __uint_as_float(x.w << 16); f[7] = __uint_as_float(x.w & 0xffff0000u); }
template <int W>
__device__ __forceinline__ void pool_rows(const bf16* U, bf16* P, int r0, int c0) {
    const int t0 = r0 & (SEQ - 1);
    v4u x[7 + W];
#pragma unroll
    for (int i = 0; i < 7 + W; ++i) { const int dr = i - (W - 1); x[i] = (t0 + dr >= 0) ? *(const GAS v4u*)(U + (size_t)(r0 + dr) * WIDE + c0) : (v4u){0u, 0u, 0u, 0u}; }
    float s[8];
#pragma unroll
    for (int e = 0; e < 8; ++e) s[e] = 0.f;
#pragma unroll
    for (int i = 0; i < W - 1; ++i) { float f[8]; unpack8(x[i], f);
#pragma unroll
        for (int e = 0; e < 8; ++e) s[e] += f[e]; }
#pragma unroll
    for (int i = 0; i < 8; ++i) {
        float cur[8]; unpack8(x[W - 1 + i], cur);
#pragma unroll
        for (int e = 0; e < 8; ++e) s[e] += cur[e];
        const int t = t0 + i; const float ic = 1.0f / (float)((t + 1 < W) ? t + 1 : W);
        v4u o; o.x = pk2(s[0] * ic - cur[0], s[1] * ic - cur[1]); o.y = pk2(s[2] * ic - cur[2], s[3] * ic - cur[3]); o.z = pk2(s[4] * ic - cur[4], s[5] * ic - cur[5]); o.w = pk2(s[6] * ic - cur[6], s[7] * ic - cur[7]);
        *(GAS v4u*)(P + (size_t)(r0 + i) * WIDE + c0) = o;
        float old[8]; unpack8(x[i], old);
#pragma unroll
        for (int e = 0; e < 8; ++e) s[e] -= old[e];
    }
}
__device__ __forceinline__ void pool_item(unsigned char* ws, int item, int wave, int lane) {
    const bf16* U = (const bf16*)(ws + WS_U); bf16* P = (bf16*)(ws + WS_BRA);
    const int g = wave & 3, c0 = g * 256 + (lane & 31) * 8, r0 = item * 64 + ((wave >> 2) * 2 + (lane >> 5)) * 16;
#pragma unroll 1
    for (int hp = 0; hp < 2; ++hp) { const int r = r0 + 8 * hp;
        if (g == 0) pool_rows<2>(U, P, r, c0); else if (g == 1) pool_rows<4>(U, P, r, c0); else if (g == 2) pool_rows<8>(U, P, r, c0); else pool_rows<16>(U, P, r, c0); }
}

__global__ void __launch_bounds__(NWAVES * 64, 2) mk_fwd(Args args) {
    extern __shared__ __attribute__((aligned(16))) unsigned char lds_raw[];
    LAS unsigned char* lds = (LAS unsigned char*)lds_raw;
    volatile LAS unsigned* MISC = (volatile LAS unsigned*)(lds + MISC_OFF);
    const int tid0 = threadIdx.x;
#define OPAQUE_TID() int tid = tid0; asm volatile("" : "+v"(tid)); const int lane = tid & 63, wave = __builtin_amdgcn_readfirstlane(tid >> 6); (void)lane; (void)wave
    const int G = gridDim.x;
    unsigned char* ws = args.ws;
    gu32* ctl = (gu32*)(ws + WS_CTL);
    for (int u = tid0; u < (LDS_BYTES - LDSCTL_OFF) / 4; u += NWAVES * 64) ((LAS unsigned*)(lds + LDSCTL_OFF))[u] = 0u;
    __syncthreads();
#if MK_PER_PHASE
    XcdBarrier bar; bar.bar = (unsigned*)(ctl + CW_BAR); bar.x = 0; bar.st = nullptr;
#define GRID_BAR() do { if (tid0 == 0) __hip_atomic_store(ctl + CW_TMO, 0xBADBA0u, RLX_AGENT); } while (0)
#else
    XcdBarrier bar = xcd_barrier_post((unsigned*)(ctl + CW_BAR), MISC + 8);
#define GRID_BAR() xcd_barrier(bar)
#endif
    const int lo = args.ph_lo, hi = args.ph_hi;
    int p = 0;
#define IN(k) (lo <= (k) && (k) < hi)
#ifndef MK_OFF
#define MK_OFF 0
#endif
#define PH_ON(n) (!((MK_OFF) & (1 << (n))))
#ifndef MK_DUP
#define MK_DUP 0
#endif
#define NREP(n) ((((MK_DUP) >> (n)) & 1) ? 2 : 1)
#ifndef MK_BAR2
#define MK_BAR2 0
#endif
#define SEAM() do { if (IN(p) && IN(p + 1)) { GRID_BAR(); if (MK_BAR2) GRID_BAR(); } ++p; } while (0)

    bf16* XB = (bf16*)(ws + WS_XB); float* SS = (float*)(ws + WS_SS);

    if (PH_ON(0) && IN(p)) for (int rep = 0; rep < NREP(0); ++rep) { OPAQUE_TID(); p0_prologue(args, lds, wave, lane, tid, G); if (rep + 1 < NREP(0)) GRID_BAR(); }
    SEAM();

    if (PH_ON(8) && IN(p)) {
        pg8::Gemm g{(const bf16*)(ws + WS_WBPT), (const bf16*)(ws + WS_WP), 16 * D, 16 * 256, 256}; pg8::FoldOrder S{(int)blockIdx.x};
        pg8::EpiFold E{(bf16*)(ws + WS_WBR), SZ_WBR / 2};
        for (int rep = 0; rep < NREP(8); ++rep) { pg8::gemm_phase<pg8::EpiFold, pg8::FoldOrder, false, true>(lds + RING_OFF, g, S, E); if (rep + 1 < NREP(8)) GRID_BAR(); }
    }
    SEAM();

    for (int j = 0; j < 2 * DEPTH; ++j) {
        const int l = j >> 1;
        if (PH_ON(1) && IN(p)) {
            pg8::Gemm g{XB, (const bf16*)(ws + WS_W13T + (size_t)j * SZ_W13T), M, 2 * DFF, D}; pg8::StaticOrder S; S.init(M, 2 * DFF, G, (int)blockIdx.x); S.rounds = 5;
            pg8::EpiSwiGLU<false> E{(bf16*)(ws + WS_H), SS, DFF};
            pg8::HalfTailOrder ST; ST.so.init(M, 2 * DFF, G, (int)blockIdx.x >> 1); ST.half = (int)blockIdx.x & 1; ST.full_rounds = 5;
            pg8::EpiSwiGLU<true> ET{(bf16*)(ws + WS_H), SS, DFF};
            for (int rep = 0; rep < NREP(1); ++rep) {
                pg8::gemm_phase<pg8::EpiSwiGLU<false>, pg8::StaticOrder, true, true>(lds + RING_OFF, g, S, E);
                pg8::gemm_phase<pg8::EpiSwiGLU<true>, pg8::HalfTailOrder, true, true, true>(lds + RING_OFF, g, ST, ET);
                if (rep + 1 < NREP(1)) GRID_BAR(); }
        }
        SEAM();
        if (PH_ON(2) && IN(p)) {
            pg8::Gemm g{(const bf16*)(ws + WS_H), (const bf16*)(ws + WS_W2T + (size_t)j * SZ_W2T), M, D, DFF}; pg8::StaticOrder S; S.init(M, D, G, (int)blockIdx.x);
            for (int rep = 0; rep < NREP(2); ++rep) { pg8::EpiResid E{j == 0 ? args.in[I_X] : (const float*)nullptr, XB, XB, SS, rep + 1 < NREP(2) ? 0.0f : 0.5f};
                pg8::gemm_phase<pg8::EpiResid, pg8::StaticOrder, false, true>(lds + RING_OFF, g, S, E); if (rep + 1 < NREP(2)) GRID_BAR(); }
        }
        SEAM();
        if (j & 1) continue;
        if (PH_ON(3) && IN(p)) {
            for (int rep = 0; rep < NREP(9); ++rep) { OPAQUE_TID(); flogit_rows(ws, l, wave, lane); }
            pg8::Gemm g{XB, (const bf16*)(ws + WS_WINT + (size_t)l * SZ_WINT), M, WIN_N, D}; pg8::StaticOrder S; S.init(M, WIN_N, G, (int)blockIdx.x);
            pg8::EpiWin E{SS, (bf16*)(ws + WS_U), (bf16*)(ws + WS_FQ), (bf16*)(ws + WS_FK), (bf16*)(ws + WS_FV), (bf16*)(ws + WS_RQ), (bf16*)(ws + WS_RK), (bf16*)(ws + WS_RV), (bf16*)(ws + WS_RG), (bf16*)(ws + WS_GATES),
                          (const float*)(ws + WS_COS), (const float*)(ws + WS_SIN)};
            for (int rep = 0; rep < NREP(3); ++rep) { pg8::gemm_phase<pg8::EpiWin, pg8::StaticOrder, true, true>(lds + RING_OFF, g, S, E); if (rep + 1 < NREP(3)) GRID_BAR(); }
        }
        SEAM();
        if (PH_ON(4) && IN(p)) {
            OPAQUE_TID();
            const float* fb = args.in[I_FB] + l * NH;
            for (int rep = 0; rep < NREP(4); ++rep) {
            gu32* head = ctl + CW_QUEUE + 64 * l + 512 * rep;
            for (;;) {
                __syncthreads();
                if (tid == 0) MISC[0] = __hip_atomic_fetch_add(head, 1u, RLX_AGENT);
                __syncthreads();
                const int it = (int)MISC[0];
                if (it >= 512 + 128) break;
                if (it < 512) { const int qb = 15 - (it >> 5), bh = it & 31; mix_unit(ws, fb, lds, bh >> 3, bh & 7, qb, wave, lane, tid); }
                else pool_item(ws, it - 512, wave, lane);
            }
            if (rep + 1 < NREP(4)) GRID_BAR(); }
        }
        SEAM();
        if (PH_ON(5) && IN(p)) {
            pg8::Gemm g{(const bf16*)(ws + WS_BRA), (const bf16*)(ws + WS_WBR + (size_t)l * SZ_WBR), 3 * M, 3 * D, WIDE}; pg8::BranchOrder S; S.so.init(M, D, G, (int)blockIdx.x);
            pg8::EpiBranch E{(const bf16*)(ws + WS_GATES), (bf16*)(ws + WS_MGB)};
            for (int rep = 0; rep < NREP(5); ++rep) { pg8::gemm_phase<pg8::EpiBranch, pg8::BranchOrder, true, true>(lds + RING_OFF, g, S, E); if (rep + 1 < NREP(5)) GRID_BAR(); }
        }
        SEAM();
        if (PH_ON(6) && IN(p)) {
            pg8::Gemm g{(const bf16*)(ws + WS_MGB), (const bf16*)(ws + WS_WOUT + (size_t)l * SZ_WOUT), M, D, D}; pg8::StaticOrder S; S.init(M, D, G, (int)blockIdx.x);
            for (int rep = 0; rep < NREP(6); ++rep) { pg8::EpiResid E{(const float*)nullptr, XB, XB, SS, rep + 1 < NREP(6) ? 0.0f : 1.0f};
                pg8::gemm_phase<pg8::EpiResid, pg8::StaticOrder, false, true>(lds + RING_OFF, g, S, E); if (rep + 1 < NREP(6)) GRID_BAR(); }
        }
        SEAM();
    }
    if (PH_ON(7) && IN(p)) {
        OPAQUE_TID();
        const unsigned bad = __hip_atomic_load(ctl + CW_TMO, RLX_AGENT) | __hip_atomic_load(ctl + CW_BAR + XB_TMO, RLX_AGENT);
        const float* gf = args.in[I_FINN];
        for (int rep = 0; rep < NREP(7); ++rep)
        for (int m = (int)blockIdx.x * NWAVES + wave; m < M; m += G * NWAVES) {
            const float rs = bad ? __builtin_nanf("") : pg8::row_rstd(SS, m);
            const GAS v4u* xr = (const GAS v4u*)(XB + (size_t)m * D) + lane; GAS f32x4* orow = (GAS f32x4*)(args.out + (size_t)m * D) + 2 * lane;
#pragma unroll
            for (int k = 0; k < 4; ++k) { const v4u w = xr[64 * k]; const GAS f32x4* gp = (const GAS f32x4*)gf + 2 * lane + 128 * k; const f32x4 g0 = gp[0], g1 = gp[1];
                orow[128 * k] = pg8::bf_lo4(w) * rs * g0; orow[128 * k + 1] = pg8::bf_hi4(w) * rs * g1; }
        }
    }
#undef IN
#undef SEAM
#undef GRID_BAR
}

extern "C" void kernel_launch(void* const* d_in, const int* in_sizes, int n_in, void* d_out, int out_size, void* d_ws, size_t ws_size, hipStream_t stream) {
    static int grid = 0;
    if (grid == 0) {
        if (n_in != 17 || in_sizes[0] != M * D || out_size != M * D || ws_size < WS_END) { fprintf(stderr, "kernel_launch: unexpected shapes (n_in %d, in0 %d, out %d, ws %zu < %zu); nothing launched\n", n_in, n_in > 0 ? in_sizes[0] : -1, out_size, ws_size, (size_t)WS_END); grid = -1; return; }
        int dev = 0, cus = 0, per_cu = 0;
        if (hipGetDevice(&dev) != hipSuccess || hipDeviceGetAttribute(&cus, hipDeviceAttributeMultiprocessorCount, dev) != hipSuccess) { grid = -1; return; }
        if (hipFuncSetAttribute((const void*)mk_fwd, hipFuncAttributeMaxDynamicSharedMemorySize, LDS_BYTES) != hipSuccess) { fprintf(stderr, "kernel_launch: hipFuncSetAttribute failed\n"); grid = -1; return; }
        if (hipOccupancyMaxActiveBlocksPerMultiprocessor(&per_cu, (const void*)mk_fwd, NWAVES * 64, LDS_BYTES) != hipSuccess || per_cu < 1) { fprintf(stderr, "kernel_launch: occupancy query says %d workgroups per CU\n", per_cu); }
        (void)hipGetLastError();
        if (cus != 256) { fprintf(stderr, "kernel_launch: built for 256 CUs, device has %d; nothing launched\n", cus); grid = -1; return; }
        grid = 256;
    }
    if (grid < 0) return;
    if (hipMemsetAsync((char*)d_ws + WS_CTL, 0, CTL_ZERO_BYTES, stream) != hipSuccess) return;
    Args a{};
    for (int i = 0; i < 17; ++i) a.in[i] = (const float*)d_in[i];
    a.out = (float*)d_out; a.ws = (unsigned char*)d_ws;
#if MK_PER_PHASE
    for (int li = 0; li < N_PHASES; ++li) { a.ph_lo = li; a.ph_hi = li + 1; a.li = li; hipLaunchKernelGGL(mk_fwd, dim3(grid), dim3(NWAVES * 64), LDS_BYTES, stream, a); }
#else
    a.ph_lo = 0; a.ph_hi = N_PHASES; a.li = 0;
    hipLaunchKernelGGL(mk_fwd, dim3(grid), dim3(NWAVES * 64), LDS_BYTES, stream, a);
#endif
    const hipError_t le = hipPeekAtLastError();
    if (le != hipSuccess) fprintf(stderr, "kernel_launch: launch failed: %s\n", hipGetErrorName(le));
}
```

```cpp
#include <hip/hip_runtime.h>
#include <cstdio>
#include <cstdint>
#include <cmath>
namespace pg8 {
#define PG8_LAS __attribute__((address_space(3)))
typedef unsigned short bf16_t;
typedef short bf16x8 __attribute__((ext_vector_type(8)));
typedef float f32x4 __attribute__((ext_vector_type(4)));
typedef unsigned u32x4 __attribute__((ext_vector_type(4)));
constexpr int BM = 256, BK = 64, HALF = 128, HTB = HALF * BK * 2  , STAGE_BYTES = 8 * HTB, NXCD = 8, WGM = 8;

__host__ __device__ __forceinline__ int lds_byte(int r, int c) { const int st = (r >> 4) * 2 + (c >> 5), rr = r & 15, cc = c & 31, ob = rr * 64 + cc * 2; return st * 1024 + (ob ^ (((ob >> 9) & 1) << 5)); }
__host__ __device__ __forceinline__ void stage_rc(int b, int& R, int& C) { const int st = b / 1024, sb = b % 1024, swz = sb ^ (((sb >> 9) & 1) << 5); R = (st >> 1) * 16 + swz / 64; C = (st & 1) * 32 + (swz % 64) / 2; }
__host__ __device__ __forceinline__ int perm32(int rho) { const int n = rho >> 4, i = rho & 15; return 8 * (i >> 2) + 4 * n + (i & 3); }

struct Unit { int pm, pn; };
struct Gemm { const bf16_t* A; const bf16_t* Bt; int M, N, K; };

struct StaticOrder {
    int nM, nN, nwg, G, c, rounds;
    __host__ __device__ void init(int M, int N, int G_, int c_) { nM = M / BM; nN = N / BM; nwg = nM * nN; G = G_; c = c_; rounds = 1 << 30; }
    __host__ __device__ bool next(int i, Unit& u) const {
        const long L = (long)i * G + c; if (L >= nwg || i >= rounds) return false;
        int wgid = (int)L; { const int q = nwg / NXCD, r = nwg % NXCD, xcd = wgid % NXCD, off = wgid / NXCD; wgid = (xcd < r ? xcd * (q + 1) : r * (q + 1) + (xcd - r) * q) + off; }
        const int nig = WGM * nN, gid = wgid / nig, fm = gid * WGM, gsz = (nM - fm) < WGM ? (nM - fm) : WGM;
        u.pm = fm + ((wgid % nig) % gsz); u.pn = (wgid % nig) / gsz; return true;
    }
    __device__ __forceinline__ void a_ready(const Unit&) const {}
    __device__ __forceinline__ void done(const Unit&) const {}
};

__device__ __forceinline__ unsigned cvt_pk_bf16(float lo, float hi) { unsigned r; asm volatile("v_cvt_pk_bf16_f32 %0, %1, %2" : "=v"(r) : "v"(lo), "v"(hi)); return r; }
typedef float f32x2 __attribute__((ext_vector_type(2)));
typedef unsigned u32x2v __attribute__((ext_vector_type(2)));
constexpr int DM = 2048;
constexpr float LOG2E = 1.4426950408889634f;
__device__ __forceinline__ float fast_sigmoid(float x) { return __builtin_amdgcn_rcpf(1.0f + __builtin_amdgcn_exp2f(-x * LOG2E)); }
__device__ __forceinline__ float fast_silu(float x) { return x * fast_sigmoid(x); }
__device__ __forceinline__ float gate_sig(float x) { return fmaxf(fast_sigmoid(x), 1e-18f); }
__device__ __forceinline__ u32x4 pack8(const f32x4 a, const f32x4 b) { u32x4 w; w.x = cvt_pk_bf16(a[0], a[1]); w.y = cvt_pk_bf16(a[2], a[3]); w.z = cvt_pk_bf16(b[0], b[1]); w.w = cvt_pk_bf16(b[2], b[3]); return w; }
__device__ __forceinline__ f32x4 bf_lo4(const u32x4 w) { return (f32x4){__uint_as_float(w.x << 16), __uint_as_float(w.x & 0xffff0000u), __uint_as_float(w.y << 16), __uint_as_float(w.y & 0xffff0000u)}; }
__device__ __forceinline__ f32x4 bf_hi4(const u32x4 w) { return (f32x4){__uint_as_float(w.z << 16), __uint_as_float(w.z & 0xffff0000u), __uint_as_float(w.w << 16), __uint_as_float(w.w & 0xffff0000u)}; }
__device__ __forceinline__ float row_rstd(const float* ss, int row) {
    const f32x4 a = *(const f32x4*)(ss + (size_t)row * 8), b = *(const f32x4*)(ss + (size_t)row * 8 + 4);
    const float s = ((a[0] + a[1]) + (a[2] + a[3])) + ((b[0] + b[1]) + (b[2] + b[3]));
    return 1.0f / sqrtf(s * (1.0f / (float)DM) + 1e-6f);
}

__device__ __forceinline__ void wave_rstd(const float* ss, int rowbase, int lane, int fr, float (&rs)[2][4]) {
    const float r0 = row_rstd(ss, rowbase + lane), r1 = row_rstd(ss, rowbase + HALF + lane);
#pragma unroll
    for (int m = 0; m < 4; ++m) { rs[0][m] = __shfl(r0, m * 16 + fr); rs[1][m] = __shfl(r1, m * 16 + fr); }
}

template <bool HALFM = false>
struct EpiSwiGLU {
    static constexpr bool PERM = true, AFTER_DRAIN = false, KEEP_ACC = false;
    bf16_t* H; const float* ss; int ldh;
    __device__ __forceinline__ void operator()(const f32x4 (&acc)[2][2][4][2], const Unit& u, int wr, int wc, int fr, int fq) const {
        const int rowb = u.pm * (HALFM ? HALF : BM) + wr * 64, row0 = rowb + fr, col0 = u.pn * HALF + wc * 32 + 8 * fq;
        float rsv[2][4]; wave_rstd(ss, rowb, fq * 16 + fr, fr, rsv);
#pragma unroll
        for (int ai = 0; ai < (HALFM ? 1 : 2); ++ai)
#pragma unroll
            for (int m = 0; m < 4; ++m) {
                const int row = row0 + ai * HALF + m * 16; const float rs = rsv[ai][m];
                f32x4 h[2];
#pragma unroll
                for (int n = 0; n < 2; ++n) { const f32x4 a = acc[ai][0][m][n] * rs, b = acc[ai][1][m][n] * rs;
                    h[n] = (f32x4){fast_silu(a[0]) * b[0], fast_silu(a[1]) * b[1], fast_silu(a[2]) * b[2], fast_silu(a[3]) * b[3]}; }
                *(u32x4*)(H + (size_t)row * ldh + col0) = pack8(h[0], h[1]);
                asm volatile("" ::: "memory");
            }
    }
};

struct EpiResid {
    static constexpr bool PERM = true, AFTER_DRAIN = true, KEEP_ACC = false;
    const float* xin32; const bf16_t* xinb; bf16_t* xb; float* ss; float coef;
    __device__ __forceinline__ void fused(f32x4 (&acc)[2][2][4][2], const Unit& u, int wr, int wc, int fr, int fq, PG8_LAS unsigned char* lds, int wid, int lane) const {
        PG8_LAS float* P = (PG8_LAS float*)lds;
        const int row0 = u.pm * BM + wr * 64 + fr, col0 = u.pn * BM + wc * 32 + 8 * fq;
#pragma unroll
        for (int ai = 0; ai < 2; ++ai) {
            f32x4 xv[4][2][2];
            if (xin32) {
#pragma unroll
                for (int m = 0; m < 4; ++m)
#pragma unroll
                    for (int bj = 0; bj < 2; ++bj) { const size_t off = (size_t)(row0 + ai * HALF + m * 16) * DM + col0 + bj * HALF; xv[m][bj][0] = *(const f32x4*)(xin32 + off); xv[m][bj][1] = *(const f32x4*)(xin32 + off + 4); }
            } else {
                u32x4 xw[4][2];
#pragma unroll
                for (int m = 0; m < 4; ++m)
#pragma unroll
                    for (int bj = 0; bj < 2; ++bj) xw[m][bj] = *(const u32x4*)(xinb + (size_t)(row0 + ai * HALF + m * 16) * DM + col0 + bj * HALF);
                asm volatile("" ::: "memory");
#pragma unroll
                for (int m = 0; m < 4; ++m)
#pragma unroll
                    for (int bj = 0; bj < 2; ++bj) { xv[m][bj][0] = bf_lo4(xw[m][bj]); xv[m][bj][1] = bf_hi4(xw[m][bj]); }
            }
            asm volatile("" ::: "memory");
#pragma unroll
            for (int m = 0; m < 4; ++m) {
                const int row = row0 + ai * HALF + m * 16; float sq = 0.f;
#pragma unroll
                for (int bj = 0; bj < 2; ++bj) { const size_t off = (size_t)row * DM + col0 + bj * HALF;
                    f32x4 v0 = xv[m][bj][0], v1 = xv[m][bj][1];
                    v0 = v0 + acc[ai][bj][m][0] * coef; v1 = v1 + acc[ai][bj][m][1] * coef;
                    *(u32x4*)(xb + off) = pack8(v0, v1);
                    sq += ((v0[0] * v0[0] + v0[1] * v0[1]) + (v0[2] * v0[2] + v0[3] * v0[3])) + ((v1[0] * v1[0] + v1[1] * v1[1]) + (v1[2] * v1[2] + v1[3] * v1[3])); }
                sq += __shfl_xor(sq, 16); sq += __shfl_xor(sq, 32);
                if (fq == 0) P[(ai * HALF + wr * 64 + m * 16 + fr) * 4 + wc] = sq;
            }
            asm volatile("" ::: "memory");
        }
        asm volatile("s_waitcnt lgkmcnt(0)" ::: "memory"); __builtin_amdgcn_s_barrier(); asm volatile("" ::: "memory");
        const int t = wid * 64 + lane;
        if (t < 256) { const f32x4 p = *(const PG8_LAS f32x4*)(P + t * 4); ss[(size_t)(u.pm * BM + t) * 8 + u.pn] = (p[0] + p[1]) + (p[2] + p[3]); }
        asm volatile("s_waitcnt lgkmcnt(0)" ::: "memory"); __builtin_amdgcn_s_barrier(); asm volatile("" ::: "memory");
    }
};

struct EpiWin {
    static constexpr bool PERM = true, AFTER_DRAIN = false, KEEP_ACC = false;
    const float* ss; bf16_t *U, *FQ, *FK, *FV, *RQ, *RK, *RV, *RG, *GATES; const float *rcos, *rsin;
    __device__ __forceinline__ void operator()(const f32x4 (&acc)[2][2][4][2], const Unit& u, int wr, int wc, int fr, int fq) const {
        const int row0 = u.pm * BM + wr * 64 + fr; const int reg = u.pn >> 2;
        if (reg == 4 || reg == 5) {
            const int head = 2 * (u.pn & 3) + (wc >> 1), j0 = 32 * (wc & 1) + 8 * fq;
            const float lg = log2f(1.0f - exp2f(-5.0f - (float)head));
            bf16_t* dst = (reg == 4) ? RQ : RK;
            float rsv[2][4]; wave_rstd(ss, u.pm * BM + wr * 64, fq * 16 + fr, fr, rsv);
#pragma unroll
            for (int ai = 0; ai < 2; ++ai)
#pragma unroll
                for (int mp = 0; mp < 2; ++mp) {
                    f32x4 cs[2][2], sn[2][2];
#pragma unroll
                    for (int mm = 0; mm < 2; ++mm) { const int t = (row0 + ai * HALF + (2 * mp + mm) * 16) & 2047;
#pragma unroll
                        for (int n = 0; n < 2; ++n) { cs[mm][n] = *(const f32x4*)(rcos + t * 64 + j0 + 4 * n); sn[mm][n] = *(const f32x4*)(rsin + t * 64 + j0 + 4 * n); } }
                    asm volatile("" ::: "memory");
#pragma unroll
                    for (int mm = 0; mm < 2; ++mm) { const int m = 2 * mp + mm, row = row0 + ai * HALF + m * 16, t = row & 2047;
                        const float sc = rsv[ai][m] * ((reg == 4) ? exp2f((float)t * lg) * 0.08838834764831845f : exp2f(-(float)t * lg));
                        f32x4 o1[2], o2[2];
#pragma unroll
                        for (int n = 0; n < 2; ++n) { const f32x4 x1 = acc[ai][0][m][n] * sc, x2 = acc[ai][1][m][n] * sc; o1[n] = x1 * cs[mm][n] - x2 * sn[mm][n]; o2[n] = x1 * sn[mm][n] + x2 * cs[mm][n]; }
                        bf16_t* p = dst + (size_t)row * 1024 + head * 128 + j0;
                        *(u32x4*)p = pack8(o1[0], o1[1]); *(u32x4*)(p + 64) = pack8(o2[0], o2[1]); }
                    asm volatile("" ::: "memory");
                }
            return;
        }
        bf16_t* dst; int ldc, colt; int act = 0; float mul = 1.f;
        if (reg < 8) { ldc = 1024; colt = (u.pn & 3) * BM;
            dst = reg == 0 ? U : reg == 1 ? FQ : reg == 2 ? FK : reg == 3 ? FV : reg == 6 ? RV : RG;
            if (reg == 1) mul = 0.08838834764831845f * LOG2E;
            if (reg == 7) act = 1; }
        else { ldc = 6144; colt = (u.pn - 32) * BM; dst = GATES; act = 2; }
        const int col0 = colt + wc * 32 + 8 * fq;
        float rsv[2][4]; wave_rstd(ss, u.pm * BM + wr * 64, fq * 16 + fr, fr, rsv);
#pragma unroll
        for (int ai = 0; ai < 2; ++ai)
#pragma unroll
            for (int m = 0; m < 4; ++m) {
                const int row = row0 + ai * HALF + m * 16; const float rs = rsv[ai][m] * mul;
#pragma unroll
                for (int bj = 0; bj < 2; ++bj) { f32x4 v0 = acc[ai][bj][m][0] * rs, v1 = acc[ai][bj][m][1] * rs;
                    if (act == 1) { v0 = (f32x4){fast_silu(v0[0]), fast_silu(v0[1]), fast_silu(v0[2]), fast_silu(v0[3])}; v1 = (f32x4){fast_silu(v1[0]), fast_silu(v1[1]), fast_silu(v1[2]), fast_silu(v1[3])}; }
                    if (act == 2) { v0 = (f32x4){gate_sig(v0[0]), gate_sig(v0[1]), gate_sig(v0[2]), gate_sig(v0[3])}; v1 = (f32x4){gate_sig(v1[0]), gate_sig(v1[1]), gate_sig(v1[2]), gate_sig(v1[3])}; }
                    *(u32x4*)(dst + (size_t)row * ldc + col0 + bj * HALF) = pack8(v0, v1); }
                asm volatile("" ::: "memory");
            }
    }
};

struct EpiBranch {
    static constexpr bool PERM = true, AFTER_DRAIN = false, KEEP_ACC = true;
    const bf16_t* GATES; bf16_t* MGB;
    __device__ __forceinline__ void operator()(f32x4 (&acc)[2][2][4][2], const Unit& u, int wr, int wc, int fr, int fq) const {
        const int br = u.pm >> 5, pm = u.pm & 31, pn = u.pn & 7;
        const int row0 = pm * BM + wr * 64 + fr, col0 = pn * BM + wc * 32 + 8 * fq;
#pragma unroll
        for (int ai = 0; ai < 2; ++ai) {
            u32x4 gc[4][2], gx[4][2];
#pragma unroll
            for (int m = 0; m < 4; ++m)
#pragma unroll
                for (int bj = 0; bj < 2; ++bj) { const bf16_t* gp = GATES + (size_t)(row0 + ai * HALF + m * 16) * 6144 + br * DM + col0 + bj * HALF;
                    gc[m][bj] = *(const u32x4*)gp; gx[m][bj] = (br < 2) ? *(const u32x4*)(gp + DM) : gc[m][bj]; }
            asm volatile("" ::: "memory");
#pragma unroll
            for (int m = 0; m < 4; ++m) {
                const int row = row0 + ai * HALF + m * 16;
#pragma unroll
                for (int bj = 0; bj < 2; ++bj) {
                    const u32x4 g = gc[m][bj]; f32x4 s0 = bf_lo4(g), s1 = bf_hi4(g);
                    if (br < 2) { const u32x4 gn = gx[m][bj]; const f32x4 d0 = bf_lo4(gn), d1 = bf_hi4(gn);
                        s0 = s0 * (f32x4){__builtin_amdgcn_rcpf(d0[0]), __builtin_amdgcn_rcpf(d0[1]), __builtin_amdgcn_rcpf(d0[2]), __builtin_amdgcn_rcpf(d0[3])}; s1 = s1 * (f32x4){__builtin_amdgcn_rcpf(d1[0]), __builtin_amdgcn_rcpf(d1[1]), __builtin_amdgcn_rcpf(d1[2]), __builtin_amdgcn_rcpf(d1[3])};
                        acc[ai][bj][m][0] = acc[ai][bj][m][0] * s0; acc[ai][bj][m][1] = acc[ai][bj][m][1] * s1; }
                    else { *(u32x4*)(MGB + (size_t)row * DM + col0 + bj * HALF) = pack8(acc[ai][bj][m][0] * s0, acc[ai][bj][m][1] * s1);
                        acc[ai][bj][m][0] = (f32x4){0.f, 0.f, 0.f, 0.f}; acc[ai][bj][m][1] = (f32x4){0.f, 0.f, 0.f, 0.f}; } }
            }
            asm volatile("" ::: "memory");
        }
    }
};
struct HalfTailOrder {
    StaticOrder so; int half, full_rounds;
    __device__ bool next(int i, Unit& u) const { if (i > 0) return false; StaticOrder s2 = so; s2.rounds = 1 << 30; Unit t; if (!s2.next(full_rounds, t)) return false; u.pm = 2 * t.pm + half; u.pn = t.pn; return true; }
    __device__ __forceinline__ void a_ready(const Unit&) const {}
    __device__ __forceinline__ void done(const Unit&) const {}
};
struct BranchOrder {
    StaticOrder so;
    __device__ bool next(int i, Unit& u) const { if (i >= 3) return false; Unit t; if (!so.next(0, t)) return false; u.pm = i * 32 + t.pm; u.pn = i * 8 + t.pn; return true; }
    __device__ __forceinline__ void a_ready(const Unit&) const {}
    __device__ __forceinline__ void done(const Unit&) const {}
};

struct EpiFold {
    static constexpr bool PERM = true, AFTER_DRAIN = false, KEEP_ACC = false;
    bf16_t* WBR; size_t layer_stride;
    __device__ __forceinline__ void operator()(const f32x4 (&acc)[2][2][4][2], const Unit& u, int wr, int wc, int fr, int fq) const {
        const int lg = u.pn, l = lg >> 2, g = lg & 3, ob = (u.pm & 7) * BM;
        bf16_t* base = WBR + (size_t)l * layer_stride + g * 256 + wc * 32 + 8 * fq;
#pragma unroll
        for (int ai = 0; ai < 2; ++ai)
#pragma unroll
            for (int m = 0; m < 4; ++m) { const int o = ob + ai * HALF + wr * 64 + m * 16 + fr;
#pragma unroll
                for (int bj = 0; bj < 2; ++bj) *(u32x4*)(base + (size_t)o * 1024 + bj * HALF) = pack8(acc[ai][bj][m][0], acc[ai][bj][m][1]); }
    }
};
struct FoldOrder {
    int c;
    __device__ bool next(int i, Unit& u) const { if (i > 0 || c >= 128) return false; u.pm = c; u.pn = c >> 3; return true; }
    __device__ __forceinline__ void a_ready(const Unit&) const {}
    __device__ __forceinline__ void done(const Unit&) const {}
};

template <class Epi, class Sched, bool ALIGN_EPI = false, bool SP2 = false, bool HALF_M = false>
__device__ __forceinline__ void gemm_phase(PG8_LAS unsigned char* lds, const Gemm g, const Sched& S, const Epi& E) {
    int tid_ = threadIdx.x; asm volatile("" : "+v"(tid_));
    const int tid = tid_, wid = __builtin_amdgcn_readfirstlane(tid >> 6), lane = tid & 63, wr = wid >> 2, wc = wid & 3, fr = lane & 15, fq = lane >> 4;
    const int K = g.K, nt = K / BK;
    unsigned voffA[2], voffB[2];
#pragma unroll
    for (int i = 0; i < 2; ++i) { int R, C; stage_rc(tid * 16 + i * 8192, R, C); const int Rb = Epi::PERM ? ((R & ~31) + perm32(R & 31)) : R;
        voffA[i] = (unsigned)(R * K + C) * 2u; voffB[i] = (unsigned)(Rb * K + C) * 2u; }
    const size_t kstep = (size_t)(BK * 2);
    const size_t hstep = (size_t)HALF * K * 2;
    const size_t tstep = 2 * hstep;
    const unsigned ldsw = (unsigned)wid * 1024u;
    const int aoff = lds_byte(wr * 64 + fr, fq * 8), boff = lds_byte(wc * 32 + fr, fq * 8);
#define PG8_SA(b, h) (((b) * 2 + (h)) * HTB)
#define PG8_SB(b, h) ((4 + (b) * 2 + (h)) * HTB)
#define PG8_STAGE(bufoff, gbase, voff) do { _Pragma("unroll") for (int _i = 0; _i < 2; ++_i) \
        __builtin_amdgcn_global_load_lds((const unsigned*)((const char*)(gbase) + (voff)[_i]), (PG8_LAS unsigned*)(lds + (bufoff) + ldsw + _i * 8192), 16, 0, 0); } while (0)
#define PG8_LDA(dst, b, h) do { _Pragma("unroll") for (int m = 0; m < 4; ++m) _Pragma("unroll") for (int k = 0; k < 2; ++k) dst[m][k] = *(const PG8_LAS bf16x8*)(lds + PG8_SA(b, h) + aoff + m * 2048 + k * 1024); } while (0)
#define PG8_LDB(dst, b, h) do { _Pragma("unroll") for (int n = 0; n < 2; ++n) _Pragma("unroll") for (int k = 0; k < 2; ++k) dst[n][k] = *(const PG8_LAS bf16x8*)(lds + PG8_SB(b, h) + boff + n * 2048 + k * 1024); } while (0)
#define PG8_MMA(ai, bj, At, Bt) do { __builtin_amdgcn_s_setprio(1); _Pragma("unroll") for (int m = 0; m < 4; ++m) _Pragma("unroll") for (int n = 0; n < 2; ++n) _Pragma("unroll") for (int k = 0; k < 2; ++k) \
        acc[ai][bj][m][n] = __builtin_amdgcn_mfma_f32_16x16x32_bf16(Bt[n][k], At[m][k], acc[ai][bj][m][n], 0, 0, 0); __builtin_amdgcn_s_setprio(0); } while (0)
#define PG8_WAIT_V(n) asm volatile("s_waitcnt vmcnt(" #n ")" ::: "memory")
#define PG8_WAIT_L(n) asm volatile("s_waitcnt lgkmcnt(" #n ")" ::: "memory")
#define PG8_BAR __builtin_amdgcn_s_barrier()
#define PG8_SCHED __builtin_amdgcn_sched_barrier(0)
    Unit cur, nxt; int ui = 0;
    if (!S.next(0, cur)) return;
    f32x4 acc[2][2][4][2];
#pragma unroll
    for (int a = 0; a < 2; ++a)
#pragma unroll
        for (int b = 0; b < 2; ++b)
#pragma unroll
            for (int m = 0; m < 4; ++m)
#pragma unroll
                for (int n = 0; n < 2; ++n) acc[a][b][m][n] = (f32x4){0.f, 0.f, 0.f, 0.f};
    bf16x8 At[4][2], B0[2][2], B1[2][2];
    const size_t mstep = HALF_M ? hstep : tstep;
    const char* cA = (const char*)g.A + (size_t)cur.pm * mstep; const char* cB = (const char*)g.Bt + (size_t)cur.pn * tstep;
    S.a_ready(cur);
    if constexpr (SP2) {
        PG8_STAGE(PG8_SB(0, 0), cB, voffB); PG8_STAGE(PG8_SB(0, 1), cB + hstep, voffB); PG8_STAGE(PG8_SA(0, 0), cA, voffA); if constexpr (!HALF_M) PG8_STAGE(PG8_SA(0, 1), cA + hstep, voffA);
        if (wr == 1) PG8_BAR;
        if constexpr (HALF_M) PG8_WAIT_V(0); else PG8_WAIT_V(2);
        PG8_BAR;
        PG8_STAGE(PG8_SB(1, 0), cB + kstep, voffB); PG8_STAGE(PG8_SA(1, 0), cA + kstep, voffA); PG8_STAGE(PG8_SB(1, 1), cB + hstep + kstep, voffB);
        PG8_WAIT_V(6); PG8_BAR;
    } else {
        PG8_STAGE(PG8_SB(0, 0), cB, voffB); PG8_STAGE(PG8_SA(0, 0), cA, voffA); PG8_STAGE(PG8_SB(0, 1), cB + hstep, voffB); PG8_STAGE(PG8_SA(0, 1), cA + hstep, voffA);
        if (wr == 1) PG8_BAR;
        PG8_WAIT_V(4); PG8_BAR;
        PG8_STAGE(PG8_SB(1, 0), cB + kstep, voffB); PG8_STAGE(PG8_SA(1, 0), cA + kstep, voffA); PG8_STAGE(PG8_SB(1, 1), cB + hstep + kstep, voffB);
        PG8_WAIT_V(6); PG8_BAR;
    }
    for (;;) {
        const bool has_next = S.next(ui + 1, nxt);
        const char* nA = has_next ? (const char*)g.A + (size_t)nxt.pm * mstep : cA; const char* nB = has_next ? (const char*)g.Bt + (size_t)nxt.pn * tstep : cB;
        for (int t = 0; t < nt; t += 2) {
            const bool last = (t == nt - 2);
            const char* a1 = cA + (size_t)(t + 1) * kstep;
            const char* a2 = last ? nA : cA + (size_t)(t + 2) * kstep; const char* b2 = last ? nB : cB + (size_t)(t + 2) * kstep;
            const char* a3 = a2 + kstep; const char* b3 = b2 + kstep;
            if (last && has_next) S.a_ready(nxt);
            if constexpr (SP2) {
            if constexpr (!HALF_M) {
            PG8_LDB(B0, 0, 0); PG8_LDB(B1, 0, 1); PG8_SCHED; PG8_LDA(At, 0, 0); PG8_STAGE(PG8_SA(1, 1), a1 + hstep, voffA);
            PG8_WAIT_V(8); PG8_WAIT_L(0); PG8_BAR; PG8_MMA(0, 0, At, B0); PG8_MMA(0, 1, At, B1); PG8_BAR; PG8_SCHED;
            PG8_LDA(At, 0, 1); PG8_STAGE(PG8_SB(0, 0), b2, voffB); PG8_STAGE(PG8_SB(0, 1), b2 + hstep, voffB); PG8_STAGE(PG8_SA(0, 0), a2, voffA);
            PG8_WAIT_V(8); PG8_WAIT_L(0); PG8_BAR; PG8_MMA(1, 0, At, B0); PG8_MMA(1, 1, At, B1); PG8_BAR; PG8_SCHED;
            PG8_LDB(B0, 1, 0); PG8_LDB(B1, 1, 1); PG8_SCHED; PG8_LDA(At, 1, 0); PG8_STAGE(PG8_SA(0, 1), a2 + hstep, voffA);
            PG8_WAIT_V(8); PG8_WAIT_L(0); PG8_BAR; PG8_MMA(0, 0, At, B0); PG8_MMA(0, 1, At, B1); PG8_BAR; PG8_SCHED;
            PG8_LDA(At, 1, 1); PG8_STAGE(PG8_SB(1, 0), b3, voffB); PG8_STAGE(PG8_SB(1, 1), b3 + hstep, voffB); PG8_STAGE(PG8_SA(1, 0), a3, voffA);
            PG8_WAIT_V(8); PG8_WAIT_L(0); PG8_BAR; PG8_MMA(1, 0, At, B0); PG8_MMA(1, 1, At, B1); PG8_BAR; PG8_SCHED;
            } else {
            (void)a1;
            PG8_LDB(B0, 0, 0); PG8_LDB(B1, 0, 1); PG8_SCHED; PG8_LDA(At, 0, 0);
            PG8_WAIT_L(0); PG8_BAR; PG8_MMA(0, 0, At, B0); PG8_MMA(0, 1, At, B1); PG8_BAR; PG8_SCHED;
            PG8_STAGE(PG8_SB(0, 0), b2, voffB); PG8_STAGE(PG8_SB(0, 1), b2 + hstep, voffB); PG8_STAGE(PG8_SA(0, 0), a2, voffA);
            PG8_WAIT_V(6); PG8_BAR; PG8_BAR; PG8_SCHED;
            PG8_LDB(B0, 1, 0); PG8_LDB(B1, 1, 1); PG8_SCHED; PG8_LDA(At, 1, 0);
            PG8_WAIT_L(0); PG8_BAR; PG8_MMA(0, 0, At, B0); PG8_MMA(0, 1, At, B1); PG8_BAR; PG8_SCHED;
            PG8_STAGE(PG8_SB(1, 0), b3, voffB); PG8_STAGE(PG8_SB(1, 1), b3 + hstep, voffB); PG8_STAGE(PG8_SA(1, 0), a3, voffA);
            PG8_WAIT_V(6); PG8_BAR; PG8_BAR; PG8_SCHED;
            }
            } else {
            PG8_LDB(B0, 0, 0); PG8_SCHED; PG8_LDA(At, 0, 0); PG8_STAGE(PG8_SA(1, 1), a1 + hstep, voffA);
            PG8_WAIT_L(8); PG8_BAR; PG8_WAIT_L(0); PG8_MMA(0, 0, At, B0); PG8_BAR; PG8_SCHED;
            PG8_LDB(B1, 0, 1); PG8_STAGE(PG8_SB(0, 0), b2, voffB);
            PG8_BAR; PG8_WAIT_L(0); PG8_MMA(0, 1, At, B1); PG8_BAR;
            PG8_LDA(At, 0, 1); PG8_STAGE(PG8_SA(0, 0), a2, voffA);
            PG8_BAR; PG8_WAIT_L(0); PG8_MMA(1, 0, At, B0); PG8_BAR; PG8_SCHED;
            PG8_STAGE(PG8_SB(0, 1), b2 + hstep, voffB);
            PG8_WAIT_V(6); PG8_BAR; PG8_MMA(1, 1, At, B1); PG8_BAR;
            PG8_LDB(B0, 1, 0); PG8_SCHED; PG8_LDA(At, 1, 0); PG8_STAGE(PG8_SA(0, 1), a2 + hstep, voffA);
            PG8_WAIT_L(8); PG8_BAR; PG8_WAIT_L(0); PG8_MMA(0, 0, At, B0); PG8_BAR; PG8_SCHED;
            PG8_LDB(B1, 1, 1); PG8_STAGE(PG8_SB(1, 0), b3, voffB);
            PG8_BAR; PG8_WAIT_L(0); PG8_MMA(0, 1, At, B1); PG8_BAR;
            PG8_LDA(At, 1, 1); PG8_STAGE(PG8_SA(1, 0), a3, voffA);
            PG8_BAR; PG8_WAIT_L(0); PG8_MMA(1, 0, At, B0); PG8_BAR; PG8_SCHED;
            PG8_STAGE(PG8_SB(1, 1), b3 + hstep, voffB);
            PG8_WAIT_V(6); PG8_BAR; PG8_MMA(1, 1, At, B1); PG8_BAR;
            }
        }
        if constexpr (ALIGN_EPI) { if (wr == 0) PG8_BAR; }
        if constexpr (!Epi::AFTER_DRAIN) { E(acc, cur, wr, wc, fr, fq); S.done(cur); }
        if (!has_next) break;
        if constexpr (!Epi::KEEP_ACC) {
#pragma unroll
        for (int a = 0; a < 2; ++a)
#pragma unroll
            for (int b = 0; b < 2; ++b)
#pragma unroll
                for (int m = 0; m < 4; ++m)
#pragma unroll
                    for (int n = 0; n < 2; ++n) acc[a][b][m][n] = (f32x4){0.f, 0.f, 0.f, 0.f};
        }
        cur = nxt; cA = nA; cB = nB; ++ui;
        if constexpr (ALIGN_EPI) { if (wr == 1) PG8_BAR; }
    }
    PG8_WAIT_V(0);
    if constexpr (!ALIGN_EPI) { if (wr == 0) PG8_BAR; }
    PG8_BAR;
    if constexpr (Epi::AFTER_DRAIN) { E.fused(acc, cur, wr, wc, fr, fq, lds, wid, lane); S.done(cur); }
#undef PG8_SA
#undef PG8_SB
#undef PG8_STAGE
#undef PG8_LDA
#undef PG8_LDB
#undef PG8_MMA
#undef PG8_WAIT_V
#undef PG8_WAIT_L
#undef PG8_BAR
#undef PG8_SCHED
}
}

constexpr int NWAVES = 8;
constexpr int BATCH = 4, SEQ = 2048, D = 2048, DEPTH = 4, M = BATCH * SEQ;
constexpr int DFF = 5632, NH = 8, HD = 128, WIDE = 1024;
constexpr int IN_W = 14344, WIN_N = 14336;
constexpr int SRC_FQ = 1024, SRC_FLOGIT = 4096, SRC_RQ = 4104, SRC_RK = 5128, SRC_RV = 6152, SRC_RG = 7176, SRC_GATES = 8200;
#ifndef MK_PER_PHASE
#define MK_PER_PHASE 0
#endif
constexpr int N_PHASES = 2 + 8 * 2 + 4 * 4 + 1;

constexpr size_t MiB = 1u << 20;
constexpr size_t WS_CTL = 0, CTL_ZERO_BYTES = 1 * MiB;
constexpr size_t WS_WF = 1 * MiB;
constexpr size_t WS_COS = 2 * MiB, WS_SIN = 2 * MiB + 512 * 1024;
constexpr size_t WS_SS = 3 * MiB;
constexpr size_t WS_FL = 3 * MiB + 512 * 1024;
constexpr size_t WS_WP = 4 * MiB;
constexpr size_t WS_WBPT = 6 * MiB;
constexpr size_t WS_W13T = 32 * MiB,  SZ_W13T = (size_t)2 * DFF * D * 2;
constexpr size_t WS_W2T = WS_W13T + 8 * SZ_W13T, SZ_W2T = (size_t)D * DFF * 2;
constexpr size_t WS_WINT = WS_W2T + 8 * SZ_W2T, SZ_WINT = (size_t)WIN_N * D * 2;
constexpr size_t WS_WBR = WS_WINT + 4 * SZ_WINT, SZ_WBR = (size_t)3 * D * WIDE * 2;
constexpr size_t WS_WOUT = WS_WBR + 4 * SZ_WBR, SZ_WOUT = (size_t)D * D * 2;
constexpr size_t WS_X = WS_WOUT + 4 * SZ_WOUT;
constexpr size_t WS_XB = WS_X + (size_t)M * D * 4;
constexpr size_t WS_H = WS_XB + (size_t)M * D * 2;
constexpr size_t SZ_ACT = (size_t)M * WIDE * 2;
constexpr size_t WS_U = WS_H + (size_t)M * DFF * 2;
constexpr size_t WS_FQ = WS_U + SZ_ACT, WS_FK = WS_FQ + SZ_ACT, WS_FV = WS_FK + SZ_ACT, WS_RQ = WS_FV + SZ_ACT, WS_RK = WS_RQ + SZ_ACT, WS_RV = WS_RK + SZ_ACT, WS_RG = WS_RV + SZ_ACT;
constexpr size_t WS_GATES = WS_RG + SZ_ACT;
constexpr size_t WS_BRA = WS_GATES + (size_t)M * 6144 * 2;
constexpr size_t WS_MG = WS_BRA + 3 * SZ_ACT;
constexpr size_t WS_MGB = WS_MG + (size_t)M * D * 4;
constexpr size_t WS_END = WS_MGB + (size_t)M * D * 2;
static_assert(WS_W13T % 256 == 0 && SZ_W13T % 256 == 0 && SZ_W2T % 256 == 0 && SZ_WINT % 256 == 0 && WS_X % 256 == 0 && WS_END < (size_t)1700 * MiB, "d_ws map");
constexpr int CW_TMO = 0, CW_CODE = 1;
constexpr int CW_QUEUE = 64;
constexpr int CW_BAR = 4096;
constexpr int RING_OFF = 0, RING_BYTES = 131072;
constexpr int LDSCTL_OFF = RING_BYTES, MISC_OFF = LDSCTL_OFF + 320;
constexpr int LDS_BYTES = 147456;
static_assert(MISC_OFF + 128 <= LDS_BYTES, "LDS map");

#define GAS __attribute__((address_space(1)))
#define LAS __attribute__((address_space(3)))
typedef unsigned short bf16;
typedef unsigned v4u __attribute__((ext_vector_type(4)));
typedef unsigned v2u __attribute__((ext_vector_type(2)));
typedef float f32x4 __attribute__((ext_vector_type(4)));
typedef float f32x16 __attribute__((ext_vector_type(16)));
typedef short bf16x8 __attribute__((ext_vector_type(8)));
typedef short s16x4 __attribute__((ext_vector_type(4)));
typedef GAS unsigned gu32;
#define RLX_AGENT __ATOMIC_RELAXED, __HIP_MEMORY_SCOPE_AGENT
#define LDS_WAIT() asm volatile("s_waitcnt lgkmcnt(0)" ::: "memory")
#define VM_WAIT() asm volatile("s_waitcnt vmcnt(0)" ::: "memory")
__device__ __forceinline__ unsigned f2bf(float f) { unsigned u = __builtin_bit_cast(unsigned, f); return (u + 0x7fffu + ((u >> 16) & 1u)) >> 16; }
__device__ __forceinline__ unsigned pk2(float lo, float hi) { return f2bf(lo) | (f2bf(hi) << 16); }
__device__ __forceinline__ float bf2f(unsigned short h) { return __uint_as_float((unsigned)h << 16); }

#define XB_TMO      128
#define XB_XCNT(j)  (256  + 64 * (j))
#define XB_XSUB(j)  (1280 + 64 * (j))
#define XB_XGEN(j)  (2304 + 64 * (j))
#define XB_TOP      3328
#define XB_TOPGEN   3392
#define XCD_BAR_WORDS 3456
#define XB_SPIN_CAP (1u << 18)

__device__ __forceinline__ unsigned xb_ld(unsigned* p)              { return __hip_atomic_load(p, __ATOMIC_RELAXED, __HIP_MEMORY_SCOPE_AGENT); }
__device__ __forceinline__ unsigned xb_add(unsigned* p, unsigned v) { return __hip_atomic_fetch_add(p, v, __ATOMIC_RELAXED, __HIP_MEMORY_SCOPE_AGENT); }
__device__ __forceinline__ unsigned xb_xcc_id() { return (unsigned)__builtin_amdgcn_s_getreg((3 << 11) | 20) & 0xFu; }
#define XB_SPIN(cond, bar) do { unsigned _sp = 0; while (cond) { __builtin_amdgcn_s_sleep(1); \
    if ((++_sp & 255u) == 0u) { if (xb_ld(&(bar)[XB_TMO])) break; if (_sp > XB_SPIN_CAP) { atomicAdd(&(bar)[XB_TMO], 1u); break; } } } } while (0)

struct XcdBarrier {
    unsigned* bar; unsigned x;
    volatile LAS unsigned* st;
};

__device__ __forceinline__ XcdBarrier xcd_barrier_post(unsigned* bar, volatile LAS unsigned* st) {
    XcdBarrier b; b.bar = bar; b.x = xb_xcc_id(); b.st = st;
    if (threadIdx.x == 0) (void)xb_add(&bar[XB_XCNT(b.x)], 1u);
    return b;
}
__device__ __forceinline__ void xcd_barrier_complete(unsigned* bar, unsigned x, unsigned& nloc, unsigned& nx) {
    const unsigned G = gridDim.x * gridDim.y * gridDim.z;
    unsigned sum, cnt, mine, sp = 0u;
    for (;;) {
        sum = 0u; cnt = 0u; mine = 0u;
#pragma unroll
        for (unsigned j = 0; j < 16; ++j) { const unsigned c = xb_ld(&bar[XB_XCNT(j)]); sum += c; cnt += (c > 0u) ? 1u : 0u; mine = (j == x) ? c : mine; }
        if (sum == G) break;
        __builtin_amdgcn_s_sleep(1);
        if ((++sp & 255u) == 0u) { if (xb_ld(&bar[XB_TMO])) break; if (sp > XB_SPIN_CAP) { atomicAdd(&bar[XB_TMO], 1u); break; } }
    }
    nloc = mine > 0u ? mine : 1u; nx = cnt > 0u ? cnt : 1u;
}

__device__ __forceinline__ void xcd_barrier(const XcdBarrier& b) {
    asm volatile("s_waitcnt vmcnt(0)" ::: "memory");
    __syncthreads();
    if (threadIdx.x == 0) {
        unsigned* bar = b.bar;
        __builtin_amdgcn_s_waitcnt(0);
        unsigned nloc = b.st[0], nx = b.st[1];
        if (nloc == 0u) { xcd_barrier_complete(bar, b.x, nloc, nx); b.st[0] = nloc; b.st[1] = nx; }
        const unsigned old = xb_add(&bar[XB_XSUB(b.x)], 1u);
        const unsigned gen = old / nloc;
        if (old + 1u == (gen + 1u) * nloc) {
            __builtin_amdgcn_fence(__ATOMIC_RELEASE, "agent");
            asm volatile("s_waitcnt vmcnt(0)" ::: "memory");
            const unsigned og = xb_add(&bar[XB_TOP], 1u);
            const unsigned tg = og / nx;
            if (og + 1u == (tg + 1u) * nx) xb_add(&bar[XB_TOPGEN], 1u);
            else XB_SPIN(xb_ld(&bar[XB_TOPGEN]) == tg, bar);
            __builtin_amdgcn_fence(__ATOMIC_ACQUIRE, "agent");
            xb_add(&bar[XB_XGEN(b.x)], 1u);
            asm volatile("s_waitcnt vmcnt(0)" ::: "memory");
        } else {
            XB_SPIN(xb_ld(&bar[XB_XGEN(b.x)]) == gen, bar);
            __builtin_amdgcn_fence(__ATOMIC_ACQUIRE, "agent");
            asm volatile("s_waitcnt vmcnt(0)" ::: "memory");
        }
    }
    __syncthreads();
}

struct Args {
    const float* in[17];
    float* out; unsigned char* ws;
    int ph_lo, ph_hi, li, pad;
};
enum { I_X = 0, I_F1N, I_F1W13, I_F1W2, I_MIXN, I_WIN, I_FB, I_POOLW, I_POOLS, I_WBP, I_WBF, I_WBRT, I_WOUT, I_F2N, I_F2W13, I_F2W2, I_FINN };

__device__ __forceinline__ float wave_sum(float v) {
#pragma unroll
    for (int o = 1; o < 64; o <<= 1) v += __shfl_xor(v, o);
    return v;
}

struct TrItem { const float* p; const float* gain; bf16* dst0; size_t ldsrc, ldd; };
__device__ __forceinline__ void tr_load(const TrItem& t, float (&va)[32], float (&vb)[32], float& gv, int lane) {
#pragma unroll
    for (int i = 0; i < 32; ++i) { va[i] = t.p[(size_t)(2 * i) * t.ldsrc]; vb[i] = t.p[(size_t)(2 * i) * t.ldsrc + 32]; }
    gv = t.gain ? t.gain[lane] : 1.0f;
}
__device__ __forceinline__ void tr_store(const TrItem& t, const float (&va)[32], const float (&vb)[32], float gv, LAS float* scr, int lane) {
    const int c = lane & 7;
#pragma unroll
    for (int hh = 0; hh < 2; ++hh) {
#pragma unroll
        for (int i = 0; i < 32; ++i) { const float g0 = __builtin_bit_cast(float, __builtin_amdgcn_readlane(__builtin_bit_cast(int, gv), 2 * i)), g1 = __builtin_bit_cast(float, __builtin_amdgcn_readlane(__builtin_bit_cast(int, gv), 2 * i + 1));
            scr[(2 * i + (lane >> 5)) * 33 + (lane & 31)] = (hh ? vb[i] : va[i]) * ((lane >> 5) ? g1 : g0); }
        LDS_WAIT(); asm volatile("" ::: "memory");
#pragma unroll
        for (int j = 0; j < 4; ++j) { const int n = (lane >> 3) + 8 * j; const LAS float* s = scr + (8 * c) * 33 + n;
            v4u o; o.x = pg8::cvt_pk_bf16(s[0 * 33], s[1 * 33]); o.y = pg8::cvt_pk_bf16(s[2 * 33], s[3 * 33]); o.z = pg8::cvt_pk_bf16(s[4 * 33], s[5 * 33]); o.w = pg8::cvt_pk_bf16(s[6 * 33], s[7 * 33]);
            *(GAS v4u*)(t.dst0 + (size_t)(32 * hh + n) * t.ldd + 8 * c) = o; }
        LDS_WAIT(); asm volatile("" ::: "memory");
    }
}
__device__ __forceinline__ int win_src_col(int d0) {
    const int reg = d0 >> 10, w = d0 & 1023;
    if (reg < 4) return d0;
    if (reg == 4 || reg == 5) { const int pu = w >> 8, c = w & 255, head = 2 * pu + ((c & 127) >> 6), d = (c >> 7) * 64 + (c & 63); return (reg == 4 ? SRC_RQ : SRC_RK) + head * 128 + d; }
    if (reg == 6) return SRC_RV + w;
    if (reg == 7) return SRC_RG + w;
    return SRC_GATES + (d0 - 8192);
}
__device__ __forceinline__ void sincos_red(float a, float& sn, float& cs) {
    const double x = (double)a; const double q = __builtin_rint(x * 0.6366197723675814); const int n = (int)q;
    const float r = (float)(x - q * 1.5707963267948966), r2 = r * r;
    const float s = r + r * r2 * (-1.6666654611e-1f + r2 * (8.3321608736e-3f + r2 * (-1.9515295891e-4f)));
    const float c = 1.0f - 0.5f * r2 + r2 * r2 * (4.166664568298827e-2f + r2 * (-1.388731625493765e-3f + r2 * 2.443315711809948e-5f));
    switch (n & 3) { case 0: sn = s; cs = c; break; case 1: sn = c; cs = -s; break; case 2: sn = -s; cs = -c; break; default: sn = -c; cs = s; break; }
}


__device__ __forceinline__ void p0_prologue(const Args& args, LAS unsigned char* lds, int wave, int lane, int tid, int G) {
    unsigned char* ws = args.ws;
    LAS float* scr = (LAS float*)(lds + RING_OFF + wave * 16384);
    const int gw = (int)blockIdx.x * NWAVES + wave, NGW = G * NWAVES;
    constexpr int I_W13 = 32 * 176, I_W2 = 88 * 32, I_IN = 32 * 224, I_BR = 16 * 32, I_OUT = 32 * 32;
    constexpr int I_LAYER = 2 * I_W13 + 2 * I_W2 + I_IN + 3 * I_BR + I_OUT, I_ALL = DEPTH * I_LAYER;
#define TR_DECODE(it, T) do { \
        const int itr_ = I_ALL - 1 - (it); const int l = itr_ / I_LAYER; int r = itr_ % I_LAYER;     \
        const float* src; size_t ldsrc; int k0, s0; const float* gain = nullptr; bf16* dst0; size_t ldd; \
        if (r < 2 * I_W13) { \
            const int f = r / I_W13; r %= I_W13; const int kb = r / 176, db = r % 176, d0 = 64 * db, pn = d0 >> 8, w = d0 & 255; \
            src = (f ? args.in[I_F2W13] : args.in[I_F1W13]) + (size_t)l * D * 2 * DFF; ldsrc = 2 * DFF; k0 = 64 * kb; s0 = (w >> 7) * DFF + pn * 128 + (w & 127); \
            gain = (f ? args.in[I_F2N] : args.in[I_F1N]) + l * D; dst0 = (bf16*)(ws + WS_W13T + (size_t)(2 * l + f) * SZ_W13T) + (size_t)d0 * D + k0; ldd = D; \
        } else if ((r -= 2 * I_W13) < 2 * I_W2) { \
            const int f = r / I_W2; r %= I_W2; const int kb = r / 32, db = r % 32; \
            src = (f ? args.in[I_F2W2] : args.in[I_F1W2]) + (size_t)l * DFF * D; ldsrc = D; k0 = 64 * kb; s0 = 64 * db; \
            dst0 = (bf16*)(ws + WS_W2T + (size_t)(2 * l + f) * SZ_W2T) + (size_t)s0 * DFF + k0; ldd = DFF; \
        } else if ((r -= 2 * I_W2) < I_IN) { \
            const int kb = r / 224, db = r % 224, d0 = 64 * db; \
            src = args.in[I_WIN] + (size_t)l * D * IN_W; ldsrc = IN_W; k0 = 64 * kb; s0 = win_src_col(d0); gain = args.in[I_MIXN] + l * D; \
            dst0 = (bf16*)(ws + WS_WINT + (size_t)l * SZ_WINT) + (size_t)d0 * D + k0; ldd = D; \
        } else if ((r -= I_IN) < 3 * I_BR) { \
            const int br = r / I_BR; r %= I_BR; const int kb = r / 32, db = r % 32; k0 = 64 * kb; s0 = 64 * db; ldsrc = D; \
            src = (br == 0 ? args.in[I_WBP] : br == 1 ? args.in[I_WBF] : args.in[I_WBRT]) + (size_t)l * WIDE * D; \
            if (br == 0) { gain = args.in[I_POOLS] + l * WIDE; \
                dst0 = (bf16*)(ws + WS_WBPT) + ((size_t)(l * 4 + (k0 >> 8)) * D + s0) * 256 + (k0 & 255); ldd = 256; } \
            else { dst0 = (bf16*)(ws + WS_WBR + (size_t)l * SZ_WBR) + (size_t)br * D * WIDE + (size_t)s0 * WIDE + k0; ldd = WIDE; } \
        } else { r -= 3 * I_BR; \
            const int kb = r / 32, db = r % 32; k0 = 64 * kb; s0 = 64 * db; ldsrc = D; \
            src = args.in[I_WOUT] + (size_t)l * D * D; dst0 = (bf16*)(ws + WS_WOUT + (size_t)l * SZ_WOUT) + (size_t)s0 * D + k0; ldd = D; \
        } \
        (T).p = src + (size_t)(k0 + (lane >> 5)) * ldsrc + s0 + (lane & 31); (T).gain = gain ? gain + k0 : nullptr; (T).dst0 = dst0; (T).ldsrc = ldsrc; (T).ldd = ldd; } while (0)
    {
        float vaA[32], vbA[32], vaB[32], vbB[32]; float gvA = 1.f, gvB = 1.f; TrItem tA, tB;
        int it = gw;
        if (it < I_ALL) { TR_DECODE(it, tA); tr_load(tA, vaA, vbA, gvA, lane); }
        for (; it < I_ALL; it += 2 * NGW) {
            const bool hasB = it + NGW < I_ALL, hasA2 = it + 2 * NGW < I_ALL;
            if (hasB) { TR_DECODE(it + NGW, tB); tr_load(tB, vaB, vbB, gvB, lane); }
            tr_store(tA, vaA, vbA, gvA, scr, lane);
            if (hasA2) { TR_DECODE(it + 2 * NGW, tA); tr_load(tA, vaA, vbA, gvA, lane); }
            if (hasB) tr_store(tB, vaB, vbB, gvB, scr, lane);
        }
    }
#undef TR_DECODE
    for (int m = gw; m < M; m += NGW) {
        const GAS f32x4* xr = (const GAS f32x4*)(args.in[I_X] + (size_t)m * D) + lane;
        GAS v2u* o8 = (GAS v2u*)((bf16*)(ws + WS_XB) + (size_t)m * D) + lane; float s = 0.f;
#pragma unroll
        for (int j = 0; j < 8; ++j) { const f32x4 v = xr[64 * j]; s += (v.x * v.x + v.y * v.y) + (v.z * v.z + v.w * v.w); v2u w; w.x = pk2(v.x, v.y); w.y = pk2(v.z, v.w); o8[64 * j] = w; }
        s = wave_sum(s);
        if (lane < 8) ((float*)(ws + WS_SS))[(size_t)m * 8 + lane] = lane == 0 ? s : 0.f;
    }
    const int gt = (int)blockIdx.x * (NWAVES * 64) + tid, NGT = G * NWAVES * 64;
    for (int i = gt; i < SEQ * 64; i += NGT) {
        const int t = i >> 6, j = i & 63; const float inv = powf(10000.0f, -(float)j / 64.0f); float sn, cs; sincos_red((float)t * inv, sn, cs);
        ((float*)(ws + WS_COS))[i] = cs; ((float*)(ws + WS_SIN))[i] = sn; }
    for (int i = gt; i < DEPTH * 4 * 256 * 256; i += NGT) ((bf16*)(ws + WS_WP))[i] = (bf16)f2bf(args.in[I_POOLW][i]);
    for (int i = gt; i < DEPTH * 8 * D; i += NGT) {
        const int l = i / (8 * D), h = (i / D) & 7, k = i % D;
        ((float*)(ws + WS_WF))[i] = args.in[I_WIN][(size_t)l * D * IN_W + (size_t)k * IN_W + SRC_FLOGIT + h] * args.in[I_MIXN][l * D + k]; }
}

__device__ __forceinline__ void flogit_rows(unsigned char* ws, int l, int wave, int lane) {
    const bf16* XBp = (const bf16*)(ws + WS_XB); const float* WF = (const float*)(ws + WS_WF) + (size_t)l * 8 * D; const float* ss = (const float*)(ws + WS_SS); float* FL = (float*)(ws + WS_FL);
    const int row0 = (int)blockIdx.x * 32 + wave * 4;
    float acc[4][8];
#pragma unroll
    for (int r = 0; r < 4; ++r)
#pragma unroll
        for (int h = 0; h < 8; ++h) acc[r][h] = 0.f;
#pragma unroll 2
    for (int j = 0; j < 8; ++j) {
        f32x4 wv[8], xv[4];
#pragma unroll
        for (int h = 0; h < 8; ++h) wv[h] = *(const f32x4*)(WF + h * D + 256 * j + 4 * lane);
#pragma unroll
        for (int r = 0; r < 4; ++r) { const v2u w = *(const GAS v2u*)(XBp + (size_t)(row0 + r) * D + 256 * j + 4 * lane);
            xv[r] = (f32x4){__uint_as_float(w.x << 16), __uint_as_float(w.x & 0xffff0000u), __uint_as_float(w.y << 16), __uint_as_float(w.y & 0xffff0000u)}; }
#pragma unroll
        for (int r = 0; r < 4; ++r)
#pragma unroll
            for (int h = 0; h < 8; ++h) acc[r][h] += (xv[r].x * wv[h].x + xv[r].y * wv[h].y) + (xv[r].z * wv[h].z + xv[r].w * wv[h].w);
    }
#pragma unroll
    for (int r = 0; r < 4; ++r) { const float rs = pg8::row_rstd(ss, row0 + r);
#pragma unroll
        for (int h = 0; h < 8; ++h) { const float s = wave_sum(acc[r][h]); if (lane == h) FL[(size_t)(row0 + r) * 8 + h] = s * rs; } }
}

__device__ __forceinline__ unsigned off_a(unsigned row, unsigned ch) { return 2048u * (row >> 3) + 512u * (ch >> 2) + 64u * (row & 7u) + 16u * ((ch & 3u) ^ ((row >> 2) & 3u)); }
typedef short v4i16_t __attribute__((ext_vector_type(4)));
__device__ __forceinline__ s16x4 vtr(const LAS unsigned char* p) { return __builtin_bit_cast(s16x4, __builtin_amdgcn_ds_read_tr16_b64_v4i16((LAS v4i16_t*)p)); }
__device__ __forceinline__ int crow(int r, int hi) { return (r & 3) + 8 * (r >> 2) + 4 * hi; }
constexpr int AT_HALF = 65536, AT_K0 = 0, AT_V0 = 32768;
constexpr int AT_NLB = LDSCTL_OFF + 1024, AT_WTOT = AT_NLB + 8192;
static_assert(AT_WTOT + 64 <= LDS_BYTES, "mixer LDS map");
constexpr float LOG2E_F = 1.4426950408889634f;

__device__ __forceinline__ void mix_nlb(unsigned char* ws, const float* fbias_l, LAS unsigned char* lds, int b, int h, int wave, int lane, int tid) {
    LAS float* nlb = (LAS float*)(lds + AT_NLB);
    __syncthreads();
    {
        const float* FL = (const float*)(ws + WS_FL) + (size_t)b * SEQ * 8 + h; const float fb = fbias_l[h];
        float v[4]; float s = 0.f;
#pragma unroll
        for (int e = 0; e < 4; ++e) { const float z = FL[(size_t)(4 * tid + e) * 8] + fb; v[e] = (fminf(z, 0.f) - log1pf(expf(-fabsf(z)))) * LOG2E_F; s += v[e]; }
        float sc = s;
#pragma unroll
        for (int o = 1; o < 64; o <<= 1) { const float t = __shfl_up(sc, o); if (lane >= o) sc += t; }
        LAS float* wtot = (LAS float*)(lds + AT_WTOT);
        if (lane == 63) wtot[wave] = sc;
        __syncthreads();
        float pre = 0.f;
        for (int w = 0; w < wave; ++w) pre += wtot[w];
        float run = pre + (sc - s);
#pragma unroll
        for (int e = 0; e < 4; ++e) { run += v[e]; nlb[4 * tid + e] = -run; }
    }
}
template <int MODE>
__device__ __forceinline__ void mix_half(unsigned char* ws, LAS unsigned char* lds_all, int b, int h, int qb, int wave, int lane) {
    LAS unsigned char* lds = lds_all + MODE * AT_HALF;
    const LAS float* nlb = (const LAS float*)(lds_all + AT_NLB);
    const int q = lane & 31, hi = lane >> 5;
    const int R0 = 128 * qb + 32 * wave, tq = R0 + q;
    const size_t rowbase = (size_t)b * SEQ;
    const bf16* Qg = (const bf16*)(ws + (MODE ? WS_RQ : WS_FQ)) + (rowbase + tq) * WIDE + h * HD;
    const bf16* Kg = (const bf16*)(ws + (MODE ? WS_RK : WS_FK)) + rowbase * WIDE + h * HD;
    const bf16* Vg = (const bf16*)(ws + (MODE ? WS_RV : WS_FV)) + rowbase * WIDE + h * HD;
    const int nt = 2 * (qb + 1);
    bf16x8 qf[8];
#pragma unroll
    for (int s = 0; s < 8; ++s) qf[s] = *(const bf16x8*)(Qg + 16 * s + 8 * hi);
    f32x16 o[4];
#pragma unroll
    for (int c = 0; c < 4; ++c)
#pragma unroll
        for (int r = 0; r < 16; ++r) o[c][r] = 0.f;
    float mrun = -1e30f, lrun = 0.f;
    unsigned stoff0;
    { const unsigned p = (unsigned)(wave * 64 + lane), row = ((p >> 7) << 3) | ((p >> 2) & 7u), ch = (((p >> 5) & 3u) << 2) | ((p & 3u) ^ ((row >> 2) & 3u)); stoff0 = row * WIDE + ch * 8u; }
#define AT_STAGE(jt, buf) do { _Pragma("unroll") for (int _i = 0; _i < 4; ++_i) { \
        __builtin_amdgcn_global_load_lds((const unsigned*)(Kg + (size_t)(64 * (jt) + 16 * _i) * WIDE + stoff0), (LAS unsigned*)(lds + AT_K0 + (buf) * 16384 + (4 * _i + wave) * 1024), 16, 0, 0); \
        __builtin_amdgcn_global_load_lds((const unsigned*)(Vg + (size_t)(64 * (jt) + 16 * _i) * WIDE + stoff0), (LAS unsigned*)(lds + AT_V0 + (buf) * 16384 + (4 * _i + wave) * 1024), 16, 0, 0); } } while (0)
    AT_STAGE(nt - 1, 0);
    asm volatile("s_waitcnt vmcnt(0)" ::: "memory");
    __syncthreads();
    unsigned kbase[2], vbase[2];
#pragma unroll
    for (int e = 0; e < 2; ++e) { kbase[e] = 2048u * ((unsigned)q >> 3) + 64u * ((unsigned)q & 7u) + 16u * ((unsigned)(2 * e + hi) ^ (((unsigned)q >> 2) & 3u)); }
    const unsigned tq_ = (unsigned)(lane & 15) >> 2, tp = (unsigned)lane & 3u, tblk = ((unsigned)lane >> 4) & 1u;
#pragma unroll
    for (int t = 0; t < 2; ++t) vbase[t] = 64u * (4u * hi + tq_) + 16u * ((2u * tblk + (tp >> 1)) ^ ((unsigned)(2 * t + hi) & 3u)) + 8u * (tp & 1u);
    for (int j = 0; j < nt; ++j) {
        const int cur = j & 1, jt = nt - 1 - j; const bool more = (j + 1 < nt);
        if (more) AT_STAGE(jt - 1, cur ^ 1);
        const bool active = (64 * jt <= R0 + 31);
        if (active) {
            const LAS unsigned char* Kt = lds + AT_K0 + cur * 16384; const LAS unsigned char* Vt = lds + AT_V0 + cur * 16384;
            f32x16 s0, s1;
            if (MODE == 0) {
#pragma unroll
                for (int g = 0; g < 4; ++g) { const f32x4 a = *(const LAS f32x4*)(nlb + 64 * jt + 8 * g + 4 * hi), c = *(const LAS f32x4*)(nlb + 64 * jt + 32 + 8 * g + 4 * hi);
#pragma unroll
                    for (int e = 0; e < 4; ++e) { s0[4 * g + e] = a[e]; s1[4 * g + e] = c[e]; } }
            } else {
#pragma unroll
                for (int r = 0; r < 16; ++r) { s0[r] = 0.f; s1[r] = 0.f; }
            }
            {
                bf16x8 kf[16];
#pragma unroll
                for (int s = 0; s < 8; ++s) { const unsigned a = kbase[s & 1] + 512u * (unsigned)(s >> 1);
                    kf[2 * s] = *(const LAS bf16x8*)(Kt + a); kf[2 * s + 1] = *(const LAS bf16x8*)(Kt + a + 8192); }
                __builtin_amdgcn_sched_barrier(0);
#pragma unroll
                for (int s = 0; s < 8; ++s) {
                    s0 = __builtin_amdgcn_mfma_f32_32x32x16_bf16(kf[2 * s], qf[s], s0, 0, 0, 0);
                    s1 = __builtin_amdgcn_mfma_f32_32x32x16_bf16(kf[2 * s + 1], qf[s], s1, 0, 0, 0);
                }
            }
            s16x4 vv[4][2][2][2];
#pragma unroll
            for (int c = 0; c < 2; ++c)
#pragma unroll
                for (int blk = 0; blk < 2; ++blk)
#pragma unroll
                    for (int st = 0; st < 2; ++st)
#pragma unroll
                        for (int t = 0; t < 2; ++t) vv[c][blk][st][t] = vtr(Vt + vbase[t] + 2048u * (unsigned)(4 * blk + 2 * st + t) + 512u * (unsigned)c);
            __builtin_amdgcn_sched_barrier(0);
            if (64 * jt + 63 > R0) {
                const float NEG = MODE == 0 ? -__builtin_inff() : 0.f;
#pragma unroll
                for (int r = 0; r < 16; ++r) { const int key = 64 * jt + crow(r, hi); if (key > tq) s0[r] = NEG; if (key + 32 > tq) s1[r] = NEG; }
            }
            if (MODE == 0) {
                float pmax = s0[0];
#pragma unroll
                for (int r = 1; r < 16; ++r) pmax = fmaxf(pmax, s0[r]);
#pragma unroll
                for (int r = 0; r < 16; ++r) pmax = fmaxf(pmax, s1[r]);
                pmax = fmaxf(pmax, __shfl_xor(pmax, 32));
                const float mn = fmaxf(mrun, pmax);
                if (__any(mn > mrun)) {
                    const float alpha = __builtin_amdgcn_exp2f(mrun - mn); mrun = mn; lrun *= alpha;
#pragma unroll
                    for (int c = 0; c < 4; ++c)
#pragma unroll
                        for (int r = 0; r < 16; ++r) o[c][r] *= alpha;
                }
                float rs = 0.f;
#pragma unroll
                for (int r = 0; r < 16; ++r) { s0[r] = __builtin_amdgcn_exp2f(s0[r] - mrun); s1[r] = __builtin_amdgcn_exp2f(s1[r] - mrun); rs += s0[r] + s1[r]; }
                lrun += rs;
            }
            bf16x8 pf[2][2];
#pragma unroll
            for (int st = 0; st < 2; ++st) {
                v4u w0, w1;
                w0.x = pg8::cvt_pk_bf16(s0[8 * st + 0], s0[8 * st + 1]); w0.y = pg8::cvt_pk_bf16(s0[8 * st + 2], s0[8 * st + 3]); w0.z = pg8::cvt_pk_bf16(s0[8 * st + 4], s0[8 * st + 5]); w0.w = pg8::cvt_pk_bf16(s0[8 * st + 6], s0[8 * st + 7]);
                w1.x = pg8::cvt_pk_bf16(s1[8 * st + 0], s1[8 * st + 1]); w1.y = pg8::cvt_pk_bf16(s1[8 * st + 2], s1[8 * st + 3]); w1.z = pg8::cvt_pk_bf16(s1[8 * st + 4], s1[8 * st + 5]); w1.w = pg8::cvt_pk_bf16(s1[8 * st + 6], s1[8 * st + 7]);
                pf[0][st] = __builtin_bit_cast(bf16x8, w0); pf[1][st] = __builtin_bit_cast(bf16x8, w1);
            }
#pragma unroll
            for (int c = 2; c < 4; ++c)
#pragma unroll
                for (int blk = 0; blk < 2; ++blk)
#pragma unroll
                    for (int st = 0; st < 2; ++st)
#pragma unroll
                        for (int t = 0; t < 2; ++t) vv[c][blk][st][t] = vtr(Vt + vbase[t] + 2048u * (unsigned)(4 * blk + 2 * st + t) + 512u * (unsigned)c);
            __builtin_amdgcn_sched_barrier(0);
#pragma unroll
            for (int c = 0; c < 4; ++c)
#pragma unroll
                for (int blk = 0; blk < 2; ++blk)
#pragma unroll
                    for (int st = 0; st < 2; ++st) {
                        const s16x4 v0 = vv[c][blk][st][0], v1 = vv[c][blk][st][1];
                        bf16x8 vf; vf[0] = v0[0]; vf[1] = v0[1]; vf[2] = v0[2]; vf[3] = v0[3]; vf[4] = v1[0]; vf[5] = v1[1]; vf[6] = v1[2]; vf[7] = v1[3];
                        o[c] = __builtin_amdgcn_mfma_f32_32x32x16_bf16(vf, pf[blk][st], o[c], 0, 0, 0);
                    }
        }
        asm volatile("s_waitcnt vmcnt(0)" ::: "memory");
        __syncthreads();
    }
#undef AT_STAGE
    bf16* Yg = (bf16*)(ws + WS_BRA + (MODE ? 2 : 1) * SZ_ACT) + (rowbase + tq) * WIDE + h * HD;
    if (MODE == 0) {
        const float lt = lrun + __shfl_xor(lrun, 32), inv = 1.0f / lt;
#pragma unroll
        for (int c = 0; c < 4; ++c)
#pragma unroll
            for (int g = 0; g < 4; ++g) { v2u w; w.x = pg8::cvt_pk_bf16(o[c][4 * g] * inv, o[c][4 * g + 1] * inv); w.y = pg8::cvt_pk_bf16(o[c][4 * g + 2] * inv, o[c][4 * g + 3] * inv);
                *(GAS v2u*)(Yg + 32 * c + 8 * g + 4 * hi) = w; }
    } else {
        float sm = 0.f;
#pragma unroll
        for (int c = 0; c < 4; ++c)
#pragma unroll
            for (int r = 0; r < 16; ++r) sm += o[c][r];
        sm += __shfl_xor(sm, 32);
        const float mu = sm * (1.0f / 128.0f); float vs = 0.f;
#pragma unroll
        for (int c = 0; c < 4; ++c)
#pragma unroll
            for (int r = 0; r < 16; ++r) { const float d = o[c][r] - mu; vs += d * d; }
        vs += __shfl_xor(vs, 32);
        const float rstd = 1.0f / sqrtf(vs * (1.0f / 128.0f) + 1e-5f);
        const bf16* Gg = (const bf16*)(ws + WS_RG) + (rowbase + tq) * WIDE + h * HD;
#pragma unroll
        for (int c = 0; c < 4; ++c)
#pragma unroll
            for (int g = 0; g < 4; ++g) { const v2u gw = *(const GAS v2u*)(Gg + 32 * c + 8 * g + 4 * hi);
                const float g0 = __uint_as_float(gw.x << 16), g1 = __uint_as_float(gw.x & 0xffff0000u), g2 = __uint_as_float(gw.y << 16), g3 = __uint_as_float(gw.y & 0xffff0000u);
                v2u w; w.x = pg8::cvt_pk_bf16((o[c][4 * g] - mu) * rstd * g0, (o[c][4 * g + 1] - mu) * rstd * g1); w.y = pg8::cvt_pk_bf16((o[c][4 * g + 2] - mu) * rstd * g2, (o[c][4 * g + 3] - mu) * rstd * g3);
                *(GAS v2u*)(Yg + 32 * c + 8 * g + 4 * hi) = w; }
    }
}

__device__ __forceinline__ void mix_unit(unsigned char* ws, const float* fbias_l, LAS unsigned char* lds, int b, int h, int qb, int wave, int lane, int tid) {
    mix_nlb(ws, fbias_l, lds, b, h, wave, lane, tid);
    if (wave < 4) mix_half<0>(ws, lds, b, h, qb, wave, lane); else mix_half<1>(ws, lds, b, h, qb, wave - 4, lane);
}

__device__ __forceinline__ void unpack8(const v4u x, float (&f)[8]) {
    f[0] = __uint_as_float(x.x << 16); f[1] = __uint_as_float(x.x & 0xffff0000u); f[2] = __uint_as_float(x.y << 16); f[3] = __uint_as_float(x.y & 0xffff0000u);
    f[4] = __uint_as_float(x.z << 16); f[5] = __uint_as_float(x.z & 0xffff0000u); f[6] = __uint_as_float(x.w << 16); f[7] = __uint_as_float(x.w & 0xffff0000u); }
template <int W>
__device__ __forceinline__ void pool_rows(const bf16* U, bf16* P, int r0, int c0) {
    const int t0 = r0 & (SEQ - 1);
    v4u x[7 + W];
#pragma unroll
    for (int i = 0; i < 7 + W; ++i) { const int dr = i - (W - 1); x[i] = (t0 + dr >= 0) ? *(const GAS v4u*)(U + (size_t)(r0 + dr) * WIDE + c0) : (v4u){0u, 0u, 0u, 0u}; }
    float s[8];
#pragma unroll
    for (int e = 0; e < 8; ++e) s[e] = 0.f;
#pragma unroll
    for (int i = 0; i < W - 1; ++i) { float f[8]; unpack8(x[i], f);
#pragma unroll
        for (int e = 0; e < 8; ++e) s[e] += f[e]; }
#pragma unroll
    for (int i = 0; i < 8; ++i) {
        float cur[8]; unpack8(x[W - 1 + i], cur);
#pragma unroll
        for (int e = 0; e < 8; ++e) s[e] += cur[e];
        const int t = t0 + i; const float ic = 1.0f / (float)((t + 1 < W) ? t + 1 : W);
        v4u o; o.x = pk2(s[0] * ic - cur[0], s[1] * ic - cur[1]); o.y = pk2(s[2] * ic - cur[2], s[3] * ic - cur[3]); o.z = pk2(s[4] * ic - cur[4], s[5] * ic - cur[5]); o.w = pk2(s[6] * ic - cur[6], s[7] * ic - cur[7]);
        *(GAS v4u*)(P + (size_t)(r0 + i) * WIDE + c0) = o;
        float old[8]; unpack8(x[i], old);
#pragma unroll
        for (int e = 0; e < 8; ++e) s[e] -= old[e];
    }
}
__device__ __forceinline__ void pool_item(unsigned char* ws, int item, int wave, int lane) {
    const bf16* U = (const bf16*)(ws + WS_U); bf16* P = (bf16*)(ws + WS_BRA);
    const int g = wave & 3, c0 = g * 256 + (lane & 31) * 8, r0 = item * 64 + ((wave >> 2) * 2 + (lane >> 5)) * 16;
#pragma unroll 1
    for (int hp = 0; hp < 2; ++hp) { const int r = r0 + 8 * hp;
        if (g == 0) pool_rows<2>(U, P, r, c0); else if (g == 1) pool_rows<4>(U, P, r, c0); else if (g == 2) pool_rows<8>(U, P, r, c0); else pool_rows<16>(U, P, r, c0); }
}

__global__ void __launch_bounds__(NWAVES * 64, 2) mk_fwd(Args args) {
    extern __shared__ __attribute__((aligned(16))) unsigned char lds_raw[];
    LAS unsigned char* lds = (LAS unsigned char*)lds_raw;
    volatile LAS unsigned* MISC = (volatile LAS unsigned*)(lds + MISC_OFF);
    const int tid0 = threadIdx.x;
#define OPAQUE_TID() int tid = tid0; asm volatile("" : "+v"(tid)); const int lane = tid & 63, wave = __builtin_amdgcn_readfirstlane(tid >> 6); (void)lane; (void)wave
    const int G = gridDim.x;
    unsigned char* ws = args.ws;
    gu32* ctl = (gu32*)(ws + WS_CTL);
    for (int u = tid0; u < (LDS_BYTES - LDSCTL_OFF) / 4; u += NWAVES * 64) ((LAS unsigned*)(lds + LDSCTL_OFF))[u] = 0u;
    __syncthreads();
#if MK_PER_PHASE
    XcdBarrier bar; bar.bar = (unsigned*)(ctl + CW_BAR); bar.x = 0; bar.st = nullptr;
#define GRID_BAR() do { if (tid0 == 0) __hip_atomic_store(ctl + CW_TMO, 0xBADBA0u, RLX_AGENT); } while (0)
#else
    XcdBarrier bar = xcd_barrier_post((unsigned*)(ctl + CW_BAR), MISC + 8);
#define GRID_BAR() xcd_barrier(bar)
#endif
    const int lo = args.ph_lo, hi = args.ph_hi;
    int p = 0;
#define IN(k) (lo <= (k) && (k) < hi)
#ifndef MK_OFF
#define MK_OFF 0
#endif
#define PH_ON(n) (!((MK_OFF) & (1 << (n))))
#ifndef MK_DUP
#define MK_DUP 0
#endif
#define NREP(n) ((((MK_DUP) >> (n)) & 1) ? 2 : 1)
#ifndef MK_BAR2
#define MK_BAR2 0
#endif
#define SEAM() do { if (IN(p) && IN(p + 1)) { GRID_BAR(); if (MK_BAR2) GRID_BAR(); } ++p; } while (0)

    bf16* XB = (bf16*)(ws + WS_XB); float* SS = (float*)(ws + WS_SS);

    if (PH_ON(0) && IN(p)) for (int rep = 0; rep < NREP(0); ++rep) { OPAQUE_TID(); p0_prologue(args, lds, wave, lane, tid, G); if (rep + 1 < NREP(0)) GRID_BAR(); }
    SEAM();

    if (PH_ON(8) && IN(p)) {
        pg8::Gemm g{(const bf16*)(ws + WS_WBPT), (const bf16*)(ws + WS_WP), 16 * D, 16 * 256, 256}; pg8::FoldOrder S{(int)blockIdx.x};
        pg8::EpiFold E{(bf16*)(ws + WS_WBR), SZ_WBR / 2};
        for (int rep = 0; rep < NREP(8); ++rep) { pg8::gemm_phase<pg8::EpiFold, pg8::FoldOrder, false, true>(lds + RING_OFF, g, S, E); if (rep + 1 < NREP(8)) GRID_BAR(); }
    }
    SEAM();

    for (int j = 0; j < 2 * DEPTH; ++j) {
        const int l = j >> 1;
        if (PH_ON(1) && IN(p)) {
            pg8::Gemm g{XB, (const bf16*)(ws + WS_W13T + (size_t)j * SZ_W13T), M, 2 * DFF, D}; pg8::StaticOrder S; S.init(M, 2 * DFF, G, (int)blockIdx.x); S.rounds = 5;
            pg8::EpiSwiGLU<false> E{(bf16*)(ws + WS_H), SS, DFF};
            pg8::HalfTailOrder ST; ST.so.init(M, 2 * DFF, G, (int)blockIdx.x >> 1); ST.half = (int)blockIdx.x & 1; ST.full_rounds = 5;
            pg8::EpiSwiGLU<true> ET{(bf16*)(ws + WS_H), SS, DFF};
            for (int rep = 0; rep < NREP(1); ++rep) {
                pg8::gemm_phase<pg8::EpiSwiGLU<false>, pg8::StaticOrder, true, true>(lds + RING_OFF, g, S, E);
                pg8::gemm_phase<pg8::EpiSwiGLU<true>, pg8::HalfTailOrder, true, true, true>(lds + RING_OFF, g, ST, ET);
                if (rep + 1 < NREP(1)) GRID_BAR(); }
        }
        SEAM();
        if (PH_ON(2) && IN(p)) {
            pg8::Gemm g{(const bf16*)(ws + WS_H), (const bf16*)(ws + WS_W2T + (size_t)j * SZ_W2T), M, D, DFF}; pg8::StaticOrder S; S.init(M, D, G, (int)blockIdx.x);
            for (int rep = 0; rep < NREP(2); ++rep) { pg8::EpiResid E{j == 0 ? args.in[I_X] : (const float*)nullptr, XB, XB, SS, rep + 1 < NREP(2) ? 0.0f : 0.5f};
                pg8::gemm_phase<pg8::EpiResid, pg8::StaticOrder, false, true>(lds + RING_OFF, g, S, E); if (rep + 1 < NREP(2)) GRID_BAR(); }
        }
        SEAM();
        if (j & 1) continue;
        if (PH_ON(3) && IN(p)) {
            for (int rep = 0; rep < NREP(9); ++rep) { OPAQUE_TID(); flogit_rows(ws, l, wave, lane); }
            pg8::Gemm g{XB, (const bf16*)(ws + WS_WINT + (size_t)l * SZ_WINT), M, WIN_N, D}; pg8::StaticOrder S; S.init(M, WIN_N, G, (int)blockIdx.x);
            pg8::EpiWin E{SS, (bf16*)(ws + WS_U), (bf16*)(ws + WS_FQ), (bf16*)(ws + WS_FK), (bf16*)(ws + WS_FV), (bf16*)(ws + WS_RQ), (bf16*)(ws + WS_RK), (bf16*)(ws + WS_RV), (bf16*)(ws + WS_RG), (bf16*)(ws + WS_GATES),
                          (const float*)(ws + WS_COS), (const float*)(ws + WS_SIN)};
            for (int rep = 0; rep < NREP(3); ++rep) { pg8::gemm_phase<pg8::EpiWin, pg8::StaticOrder, true, true>(lds + RING_OFF, g, S, E); if (rep + 1 < NREP(3)) GRID_BAR(); }
        }
        SEAM();
        if (PH_ON(4) && IN(p)) {
            OPAQUE_TID();
            const float* fb = args.in[I_FB] + l * NH;
            for (int rep = 0; rep < NREP(4); ++rep) {
            gu32* head = ctl + CW_QUEUE + 64 * l + 512 * rep;
            for (;;) {
                __syncthreads();
                if (tid == 0) MISC[0] = __hip_atomic_fetch_add(head, 1u, RLX_AGENT);
                __syncthreads();
                const int it = (int)MISC[0];
                if (it >= 512 + 128) break;
                if (it < 128) pool_item(ws, it, wave, lane);
                else { const int iu = it - 128, qb = 15 - (iu >> 5), bh = iu & 31; mix_unit(ws, fb, lds, bh >> 3, bh & 7, qb, wave, lane, tid); }
            }
            if (rep + 1 < NREP(4)) GRID_BAR(); }
        }
        SEAM();
        if (PH_ON(5) && IN(p)) {
            pg8::Gemm g{(const bf16*)(ws + WS_BRA), (const bf16*)(ws + WS_WBR + (size_t)l * SZ_WBR), 3 * M, 3 * D, WIDE}; pg8::BranchOrder S; S.so.init(M, D, G, (int)blockIdx.x);
            pg8::EpiBranch E{(const bf16*)(ws + WS_GATES), (bf16*)(ws + WS_MGB)};
            for (int rep = 0; rep < NREP(5); ++rep) { pg8::gemm_phase<pg8::EpiBranch, pg8::BranchOrder, true, true>(lds + RING_OFF, g, S, E); if (rep + 1 < NREP(5)) GRID_BAR(); }
        }
        SEAM();
        if (PH_ON(6) && IN(p)) {
            pg8::Gemm g{(const bf16*)(ws + WS_MGB), (const bf16*)(ws + WS_WOUT + (size_t)l * SZ_WOUT), M, D, D}; pg8::StaticOrder S; S.init(M, D, G, (int)blockIdx.x);
            for (int rep = 0; rep < NREP(6); ++rep) { pg8::EpiResid E{(const float*)nullptr, XB, XB, SS, rep + 1 < NREP(6) ? 0.0f : 1.0f};
                pg8::gemm_phase<pg8::EpiResid, pg8::StaticOrder, false, true>(lds + RING_OFF, g, S, E); if (rep + 1 < NREP(6)) GRID_BAR(); }
        }
        SEAM();
    }
    if (PH_ON(7) && IN(p)) {
        OPAQUE_TID();
        const unsigned bad = __hip_atomic_load(ctl + CW_TMO, RLX_AGENT) | __hip_atomic_load(ctl + CW_BAR + XB_TMO, RLX_AGENT);
        const float* gf = args.in[I_FINN];
        for (int rep = 0; rep < NREP(7); ++rep)
        for (int m = (int)blockIdx.x * NWAVES + wave; m < M; m += G * NWAVES) {
            const float rs = bad ? __builtin_nanf("") : pg8::row_rstd(SS, m);
            const GAS v4u* xr = (const GAS v4u*)(XB + (size_t)m * D) + lane; GAS f32x4* orow = (GAS f32x4*)(args.out + (size_t)m * D) + 2 * lane;
#pragma unroll
            for (int k = 0; k < 4; ++k) { const v4u w = xr[64 * k]; const GAS f32x4* gp = (const GAS f32x4*)gf + 2 * lane + 128 * k; const f32x4 g0 = gp[0], g1 = gp[1];
                orow[128 * k] = pg8::bf_lo4(w) * rs * g0; orow[128 * k + 1] = pg8::bf_hi4(w) * rs * g1; }
        }
    }
#undef IN
#undef SEAM
#undef GRID_BAR
}

extern "C" void kernel_launch(void* const* d_in, const int* in_sizes, int n_in, void* d_out, int out_size, void* d_ws, size_t ws_size, hipStream_t stream) {
    static int grid = 0;
    if (grid == 0) {
        if (n_in != 17 || in_sizes[0] != M * D || out_size != M * D || ws_size < WS_END) { fprintf(stderr, "kernel_launch: unexpected shapes (n_in %d, in0 %d, out %d, ws %zu < %zu); nothing launched\n", n_in, n_in > 0 ? in_sizes[0] : -1, out_size, ws_size, (size_t)WS_END); grid = -1; return; }
        int dev = 0, cus = 0, per_cu = 0;
        if (hipGetDevice(&dev) != hipSuccess || hipDeviceGetAttribute(&cus, hipDeviceAttributeMultiprocessorCount, dev) != hipSuccess) { grid = -1; return; }
        if (hipFuncSetAttribute((const void*)mk_fwd, hipFuncAttributeMaxDynamicSharedMemorySize, LDS_BYTES) != hipSuccess) { fprintf(stderr, "kernel_launch: hipFuncSetAttribute failed\n"); grid = -1; return; }
        if (hipOccupancyMaxActiveBlocksPerMultiprocessor(&per_cu, (const void*)mk_fwd, NWAVES * 64, LDS_BYTES) != hipSuccess || per_cu < 1) { fprintf(stderr, "kernel_launch: occupancy query says %d workgroups per CU\n", per_cu); }
        (void)hipGetLastError();
        if (cus != 256) { fprintf(stderr, "kernel_launch: built for 256 CUs, device has %d; nothing launched\n", cus); grid = -1; return; }
        grid = 256;
    }
    if (grid < 0) return;
    if (hipMemsetAsync((char*)d_ws + WS_CTL, 0, CTL_ZERO_BYTES, stream) != hipSuccess) return;
    Args a{};
    for (int i = 0; i < 17; ++i) a.in[i] = (const float*)d_in[i];
    a.out = (float*)d_out; a.ws = (unsigned char*)d_ws;
#if MK_PER_PHASE
    for (int li = 0; li < N_PHASES; ++li) { a.ph_lo = li; a.ph_hi = li + 1; a.li = li; hipLaunchKernelGGL(mk_fwd, dim3(grid), dim3(NWAVES * 64), LDS_BYTES, stream, a); }
#else
    a.ph_lo = 0; a.ph_hi = N_PHASES; a.li = 0;
    hipLaunchKernelGGL(mk_fwd, dim3(grid), dim3(NWAVES * 64), LDS_BYTES, stream, a);
#endif
    const hipError_t le = hipPeekAtLastError();
    if (le != hipSuccess) fprintf(stderr, "kernel_launch: launch failed: %s\n", hipGetErrorName(le));
}
```
